# Optimizing an MI355X kernel written in HIP

```python
import jax, jax.numpy as jnp
from jax import lax
import numpy as np

D_MODEL = 2048
BATCH = 8
SEQ = 2048
DEPTH = 4

GRID_W = 64
CTX_LEN = 256
HEAD_DIM = 128
A_HEADS = 8
A_KV_HEADS = 2
WINDOW = 128
A_BLOCK = 128
B_HEADS = 8
B_KV_HEADS = 2
Q_BLOCK = 128
C_HEADS = 8
C_DK = 128
C_DV = 128
C_CHUNK = 64
A_WIDTH = A_HEADS * HEAD_DIM
B_WIDTH = B_HEADS * HEAD_DIM
C_WIDTH = C_HEADS * C_DV
N_BRANCH = 3
ROPE_THETA = 10000.0
NORM_EPS = 1e-6
IN_SPLITS = (A_WIDTH, A_KV_HEADS * HEAD_DIM, A_KV_HEADS * HEAD_DIM, A_WIDTH,
             B_WIDTH, B_KV_HEADS * HEAD_DIM, B_KV_HEADS * HEAD_DIM, B_WIDTH,
             C_HEADS * C_DK, C_HEADS * C_DK, C_HEADS * C_DK, C_WIDTH, C_WIDTH,
             N_BRANCH * D_MODEL)
W_IN_TOTAL = sum(IN_SPLITS)

kernel_name = "hybrid_gated_branch_dit_block"

F32 = jnp.float32


def rms_norm(x, g):
    xf = x.astype(F32)
    y = xf * lax.rsqrt(jnp.mean(xf * xf, axis=-1, keepdims=True) + NORM_EPS)
    return (y * g.astype(F32)).astype(x.dtype)


def axial_rope_tables(n):
    rows = n // GRID_W
    row = jnp.repeat(jnp.arange(rows, dtype=F32), GRID_W)
    col = jnp.tile(jnp.arange(GRID_W, dtype=F32), rows)
    n_freq = HEAD_DIM // 4
    inv_freq = ROPE_THETA ** (-jnp.arange(n_freq, dtype=F32) / n_freq)
    ang = jnp.concatenate([row[:, None] * inv_freq, col[:, None] * inv_freq], axis=-1)
    ang = jnp.concatenate([ang, ang], axis=-1)
    return jnp.cos(ang), jnp.sin(ang)


def apply_rope(x, cos, sin):
    xf = x.astype(F32)
    x1, x2 = jnp.split(xf, 2, axis=-1)
    rot = jnp.concatenate([-x2, x1], axis=-1)
    return (xf * cos[:, None] + rot * sin[:, None]).astype(x.dtype)


def sink_softmax(s, sink):
    col = jnp.broadcast_to(sink[None, :, :, None, None], s.shape[:-1] + (1,))
    return jax.nn.softmax(jnp.concatenate([s, col], axis=-1), axis=-1)[..., :-1]


def window_sink_attention(q_c, k_c, v_c, q_l, k_l, v_l, sink, with_ctx):
    b, n = q_l.shape[:2]
    m = q_c.shape[1]
    g = A_HEADS // A_KV_HEADS
    scale = HEAD_DIM ** -0.5
    sink = sink.astype(F32).reshape(A_KV_HEADS, g)
    nb = n // A_BLOCK
    qb = jnp.moveaxis(q_l.reshape(b, nb, A_BLOCK, A_KV_HEADS, g, HEAD_DIM), 1, 0)

    def band(t):
        tb = jnp.pad(t, ((0, 0), (A_BLOCK, A_BLOCK), (0, 0), (0, 0)))
        tb = tb.reshape(b, nb + 2, A_BLOCK, A_KV_HEADS, HEAD_DIM)
        return jnp.moveaxis(jnp.concatenate([tb[:, :-2], tb[:, 1:-1], tb[:, 2:]], axis=2), 1, 0)

    kw, vw = band(k_l), band(v_l)
    blk = jnp.arange(nb)[:, None, None]
    qpos = blk * A_BLOCK + jnp.arange(A_BLOCK)[None, :, None]
    kpos = (blk - 1) * A_BLOCK + jnp.arange(3 * A_BLOCK)[None, None, :]
    valid = (jnp.abs(qpos - kpos) <= WINDOW) & (kpos >= 0) & (kpos < n)

    def block(args):
        qblk, kblk, vblk, mask = args
        s_win = jnp.einsum('bqhgd,bkhd->bhgqk', qblk, kblk).astype(F32) * scale
        s_win = jnp.where(mask, s_win, -jnp.inf)
        s_ctx = jnp.einsum('bqhgd,bkhd->bhgqk', qblk, k_c).astype(F32) * scale
        p = sink_softmax(jnp.concatenate([s_win, s_ctx], axis=-1), sink).astype(vblk.dtype)
        return (jnp.einsum('bhgqk,bkhd->bqhgd', p[..., :3 * A_BLOCK], vblk)
                + jnp.einsum('bhgqk,bkhd->bqhgd', p[..., 3 * A_BLOCK:], v_c))

    o_l = jnp.moveaxis(lax.map(block, (qb, kw, vw, valid)), 0, 1).reshape(b, n, A_WIDTH)
    o_c = None
    if with_ctx:
        qc = q_c.reshape(b, m, A_KV_HEADS, g, HEAD_DIM)
        s = jnp.einsum('bqhgd,bkhd->bhgqk', qc, k_c).astype(F32) * scale
        p = sink_softmax(s, sink).astype(v_c.dtype)
        o_c = jnp.einsum('bhgqk,bkhd->bqhgd', p, v_c).reshape(b, m, A_WIDTH)
    return o_c, o_l


def dense_qknorm_attention(q_c, k_c, v_c, q_l, k_l, v_l, with_ctx):
    b, n = q_l.shape[:2]
    m = q_c.shape[1]
    g = B_HEADS // B_KV_HEADS
    scale = HEAD_DIM ** -0.5
    k_all = jnp.concatenate([k_c, k_l], axis=1)
    v_all = jnp.concatenate([v_c, v_l], axis=1)
    nb = n // Q_BLOCK
    qb = jnp.moveaxis(q_l.reshape(b, nb, Q_BLOCK, B_KV_HEADS, g, HEAD_DIM), 1, 0)

    def block(qblk):
        s = jnp.einsum('bqhgd,bkhd->bhgqk', qblk, k_all).astype(F32) * scale
        p = jax.nn.softmax(s, axis=-1).astype(v_all.dtype)
        return jnp.einsum('bhgqk,bkhd->bqhgd', p, v_all)

    o_l = jnp.moveaxis(lax.map(block, qb), 0, 1).reshape(b, n, B_WIDTH)
    o_c = None
    if with_ctx:
        qc = q_c.reshape(b, m, B_KV_HEADS, g, HEAD_DIM)
        s = jnp.einsum('bqhgd,bkhd->bhgqk', qc, k_c).astype(F32) * scale
        p = jax.nn.softmax(s, axis=-1).astype(v_c.dtype)
        o_c = jnp.einsum('bhgqk,bkhd->bqhgd', p, v_c).reshape(b, m, B_WIDTH)
    return o_c, o_l


def hgrn2_gates(z, lb):
    log_f = jnp.logaddexp(jnp.log(lb), jnp.log1p(-lb) + jax.nn.log_sigmoid(z))
    k = (1.0 - lb) * jax.nn.sigmoid(-z)
    return log_f, k


def chunk_scan(q, k, v, log_f, s0):
    b, L, h, dk = q.shape
    nc = L // C_CHUNK

    def chunks(t):
        return t.reshape(b, nc, C_CHUNK, h, t.shape[-1]).transpose(1, 0, 3, 2, 4)

    tri = jnp.tril(jnp.ones((C_CHUNK, C_CHUNK), dtype=bool))[:, :, None]

    def step(S, inp):
        qc, kc, vc, gc = inp
        cum = jnp.cumsum(gc, axis=2)
        rel = cum[:, :, :, None, :] - cum[:, :, None, :, :]
        decay = jnp.exp(jnp.where(tri, rel, -jnp.inf))
        attn = jnp.einsum('bhtk,bhsk,bhtsk->bhts', qc, kc, decay)
        o = attn @ vc + jnp.einsum('bhtk,bhkv->bhtv', qc * jnp.exp(cum), S)
        tot = cum[:, :, -1:, :]
        S = (jnp.exp(tot[:, :, 0, :, None]) * S
             + jnp.einsum('bhsk,bhsv->bhkv', kc * jnp.exp(tot - cum), vc))
        return S, o

    S, o = lax.scan(step, s0, (chunks(q), chunks(k), chunks(v), chunks(log_f)))
    o = o.transpose(1, 0, 3, 2, 4).reshape(b, L, h, v.shape[-1])
    return o, S


def hgrn2_bidirectional(q, i, z_f, z_b, lb, gain, m, with_ctx):
    b, t, h, dk = q.shape
    dv = i.shape[-1]
    q = q.astype(F32) * dk ** -0.5
    i = i.astype(F32)
    s0 = jnp.zeros((b, h, dk, dv), F32)
    outs = []
    for z, lb_d, rev in ((z_f, lb[0], False), (z_b, lb[1], True)):
        log_f, k = hgrn2_gates(z.astype(F32), lb_d.reshape(h, dk))
        flip = (lambda a: jnp.flip(a, axis=1)) if rev else (lambda a: a)
        o_c, s_c = chunk_scan(flip(q[:, :m]), flip(k[:, :m]), flip(i[:, :m]), flip(log_f[:, :m]), s0)
        o_l, _ = chunk_scan(flip(q[:, m:]), flip(k[:, m:]), flip(i[:, m:]), flip(log_f[:, m:]), s_c)
        outs.append(jnp.concatenate([flip(o_c), flip(o_l)], axis=1) if with_ctx else flip(o_l))
    o = rms_norm(outs[0] + outs[1], gain)
    return o.reshape(b, o.shape[1], h * dv)


def join(o_c, o_l, with_ctx):
    return jnp.concatenate([o_c, o_l], axis=1) if with_ctx else o_l


def hybrid_layer(x_lat, x_ctx, c, c_ctx, ada_w, ada_b, norm_g, w_in, a_sink, b_qn, b_kn,
                 lb, c_gn, w_ba, w_bb, w_bc, w_out, cos, sin, with_ctx):
    b, n, _ = x_lat.shape
    m = x_ctx.shape[1]
    sh_l, sc_l, gt_l = jnp.split(jax.nn.silu(c) @ ada_w + ada_b, 3, axis=-1)
    sh_c, sc_c, gt_c = jnp.split(jax.nn.silu(c_ctx) @ ada_w + ada_b, 3, axis=-1)
    h_lat = rms_norm(x_lat, norm_g) * (1.0 + sc_l[:, None]) + sh_l[:, None]
    h_ctx = rms_norm(x_ctx, norm_g) * (1.0 + sc_c) + sh_c
    h = jnp.concatenate([h_ctx, h_lat], axis=1)
    w_parts = jnp.split(w_in, np.cumsum(IN_SPLITS)[:-1].tolist(), axis=1)
    (a_q, a_k, a_v, a_z, b_q, b_k, b_v, b_z,
     c_q, c_zf, c_zb, c_i, c_z, br_gate) = [h @ w for w in w_parts]

    def heads(t, nh, d=HEAD_DIM):
        return t.reshape(b, m + n, nh, d)

    aq, ak, av = heads(a_q, A_HEADS), heads(a_k, A_KV_HEADS), heads(a_v, A_KV_HEADS)
    oa_c, oa_l = window_sink_attention(aq[:, :m], ak[:, :m], av[:, :m],
                                       apply_rope(aq[:, m:], cos, sin), apply_rope(ak[:, m:], cos, sin),
                                       av[:, m:], a_sink, with_ctx)
    bq = rms_norm(heads(b_q, B_HEADS), b_qn)
    bk = rms_norm(heads(b_k, B_KV_HEADS), b_kn)
    bv = heads(b_v, B_KV_HEADS)
    ob_c, ob_l = dense_qknorm_attention(bq[:, :m], bk[:, :m], bv[:, :m],
                                        apply_rope(bq[:, m:], cos, sin), apply_rope(bk[:, m:], cos, sin),
                                        bv[:, m:], with_ctx)
    oc = hgrn2_bidirectional(heads(c_q, C_HEADS, C_DK), heads(c_i, C_HEADS, C_DV),
                             heads(c_zf, C_HEADS, C_DK), heads(c_zb, C_HEADS, C_DK),
                             lb, c_gn, m, with_ctx).astype(x_lat.dtype)

    q0 = 0 if with_ctx else m
    y_a = (join(oa_c, oa_l, with_ctx) * jax.nn.silu(a_z[:, q0:])) @ w_ba
    y_b = (join(ob_c, ob_l, with_ctx) * jax.nn.silu(b_z[:, q0:])) @ w_bb
    y_c = (oc * jax.nn.silu(c_z[:, q0:])) @ w_bc
    g_a, g_b, g_c = jnp.split(jax.nn.sigmoid(br_gate[:, q0:]), 3, axis=-1)
    out = (g_a * y_a + g_b * y_b + g_c * y_c) @ w_out
    new_lat = x_lat + gt_l[:, None] * out[:, -n:]
    new_ctx = x_ctx + gt_c * out[:, :m] if with_ctx else x_ctx
    return new_lat, new_ctx


def setup_inputs(seed: int = 0) -> dict:
    key = jax.random.key(seed)
    ks = jax.random.split(key, 20)
    d = D_MODEL

    def nrm(k, shape, scale):
        return jax.random.normal(k, shape, F32) * scale

    return {
        "x": nrm(ks[0], (BATCH, SEQ, d), 1.0),
        "c": nrm(ks[1], (BATCH, d), 1.0),
        "ctx": nrm(ks[2], (BATCH, CTX_LEN, d), 1.0),
        "c_ctx": nrm(ks[3], (d,), 1.0),
        "ada_w": nrm(ks[4], (DEPTH, d, 3 * d), 0.5 * d ** -0.5),
        "ada_b": nrm(ks[5], (DEPTH, 3 * d), 0.02),
        "norm_g": 1.0 + nrm(ks[6], (DEPTH, d), 0.02),
        "w_in": nrm(ks[7], (DEPTH, d, W_IN_TOTAL), d ** -0.5),
        "a_sink": nrm(ks[8], (DEPTH, A_HEADS), 0.5),
        "b_q_norm": 1.0 + nrm(ks[9], (DEPTH, HEAD_DIM), 0.02),
        "b_k_norm": 1.0 + nrm(ks[10], (DEPTH, HEAD_DIM), 0.02),
        "c_lower_bound": nrm(ks[11], (DEPTH, 2, C_HEADS * C_DK), 0.1),
        "c_out_norm": 1.0 + nrm(ks[12], (DEPTH, C_DV), 0.02),
        "w_branch_a": nrm(ks[13], (DEPTH, A_WIDTH, d), A_WIDTH ** -0.5),
        "w_branch_b": nrm(ks[14], (DEPTH, B_WIDTH, d), B_WIDTH ** -0.5),
        "w_branch_c": nrm(ks[15], (DEPTH, C_WIDTH, d), C_WIDTH ** -0.5),
        "w_out": nrm(ks[16], (DEPTH, d, d), d ** -0.5),
        "final_norm_g": 1.0 + nrm(ks[17], (d,), 0.02),
    }


def reference(x, c, ctx, c_ctx, ada_w, ada_b, norm_g, w_in, a_sink, b_q_norm, b_k_norm,
              c_lower_bound, c_out_norm, w_branch_a, w_branch_b, w_branch_c, w_out, final_norm_g):
    n = x.shape[1]
    cos, sin = axial_rope_tables(n)
    lb_all = jnp.cumsum(jax.nn.softmax(c_lower_bound.astype(F32), axis=0), axis=0)
    lb_all = lb_all - lb_all[0:1]
    h_lat, h_ctx = x, ctx
    for l in range(DEPTH):
        h_lat, h_ctx = hybrid_layer(h_lat, h_ctx, c, c_ctx, ada_w[l], ada_b[l], norm_g[l], w_in[l],
                                    a_sink[l], b_q_norm[l], b_k_norm[l], lb_all[l], c_out_norm[l],
                                    w_branch_a[l], w_branch_b[l], w_branch_c[l], w_out[l],
                                    cos, sin, l < DEPTH - 1)
    return rms_norm(h_lat, final_norm_g)
```

```cpp
#include <hip/hip_runtime.h>
#include <hip/hip_bf16.h>
#include <hip/hip_cooperative_groups.h>
#include <cstdio>
#include <cstdint>
namespace cg = cooperative_groups;

constexpr int NB = 8, SEQ = 2048, CTXL = 256, TPB = SEQ + CTXL, TT = NB * TPB, DM = 2048, NP = 16384, DEPTH = 4;
constexpr int COL_AQ = 0, COL_AK = 1024, COL_AV = 1280, COL_AZ = 1536, COL_BQ = 2560, COL_BK = 3584, COL_BV = 3840, COL_BZ = 4096;
constexpr int COL_CQ = 5120, COL_CZF = 6144, COL_CZB = 7168, COL_CI = 8192, COL_CZ = 9216, COL_GATE = 10240;
constexpr int LDS_BYTES = 131072;
typedef unsigned short bf16_t;

struct Params {
    const float* x; const float* c; const float* ctx; const float* c_ctx; const float* ada_w; const float* ada_b; const float* norm_g; const float* w_in;
    const float* a_sink; const float* b_qn; const float* b_kn; const float* clb; const float* c_gn; const float* w_ba; const float* w_bb; const float* w_bc;
    const float* w_out; const float* final_g;
    float* out;
    bf16_t* WinT; bf16_t* WbT; bf16_t* WoT; float* resid; bf16_t* hbuf; bf16_t* proj; bf16_t* gin; float* pbuf; float* mod; float* lbv; float* cos_t; float* sin_t;
};

__device__ __forceinline__ float bf2f(bf16_t u) { return __uint_as_float(((unsigned)u) << 16); }
typedef __bf16 bf16x2_ __attribute__((ext_vector_type(2)));
__device__ __forceinline__ unsigned cvtpk2(float lo, float hi) { bf16x2_ v; v[0] = (__bf16)lo; v[1] = (__bf16)hi; return __builtin_bit_cast(unsigned, v); }
__device__ __forceinline__ bf16_t f2bf(float f) { return (bf16_t)(cvtpk2(f, f) & 0xffffu); }
__device__ __forceinline__ float sigmoidf_(float z) { return 1.f / (1.f + __expf(-z)); }
__device__ __forceinline__ float siluf_(float z) { return z / (1.f + __expf(-z)); }
__device__ __forceinline__ float wave_sum(float v) {
#pragma unroll
    for (int o = 32; o >= 1; o >>= 1) v += __shfl_xor(v, o);
    return v;
}

__device__ __forceinline__ int tidx() { int t = threadIdx.x; asm volatile("" : "+v"(t)); return t; }
namespace pg8 {
#define PG8_LAS __attribute__((address_space(3)))
typedef unsigned short bf16_t;
typedef short bf16x8 __attribute__((ext_vector_type(8)));
typedef float f32x4 __attribute__((ext_vector_type(4)));
typedef unsigned u32x4 __attribute__((ext_vector_type(4)));
constexpr int BM = 256, BK = 64, HALF = 128, HTB = HALF * BK * 2  , STAGE_BYTES = 8 * HTB, NXCD = 8, WGM = 8;

__host__ __device__ __forceinline__ int lds_byte(int r, int c) { const int st = (r >> 4) * 2 + (c >> 5), rr = r & 15, cc = c & 31, ob = rr * 64 + cc * 2; return st * 1024 + (ob ^ (((ob >> 9) & 1) << 5)); }
__host__ __device__ __forceinline__ void stage_rc(int b, int& R, int& C) { const int st = b / 1024, sb = b % 1024, swz = sb ^ (((sb >> 9) & 1) << 5); R = (st >> 1) * 16 + swz / 64; C = (st & 1) * 32 + (swz % 64) / 2; }
__host__ __device__ __forceinline__ int perm32(int rho) { const int n = rho >> 4, i = rho & 15; return 8 * (i >> 2) + 4 * n + (i & 3); }

struct Unit { int pm, pn; };
struct Gemm { const bf16_t* A; const bf16_t* Bt; int M, N, K; };

struct StaticOrder {
    int nM, nN, nwg, G, c;
    __host__ __device__ void init(int M, int N, int G_, int c_) { nM = M / BM; nN = N / BM; nwg = nM * nN; G = G_; c = c_; }
    __host__ __device__ bool next(int i, Unit& u) const {
        const long L = (long)i * G + c; if (L >= nwg) return false;
        int wgid = (int)L; { const int q = nwg / NXCD, r = nwg % NXCD, xcd = wgid % NXCD, off = wgid / NXCD; wgid = (xcd < r ? xcd * (q + 1) : r * (q + 1) + (xcd - r) * q) + off; }
        const int nig = WGM * nN, gid = wgid / nig, fm = gid * WGM, gsz = (nM - fm) < WGM ? (nM - fm) : WGM;
        u.pm = fm + ((wgid % nig) % gsz); u.pn = (wgid % nig) / gsz; return true;
    }
    __device__ __forceinline__ void a_ready(const Unit&) const {}
    __device__ __forceinline__ void done(const Unit&) const {}
};

template <class Epi, class Sched, bool STAMP = false>
__device__ __forceinline__ void gemm_phase(PG8_LAS unsigned char* lds, const Gemm g, const Sched& S, const Epi& E, unsigned long long* stamps) {
    const int tid = tidx(), wid = __builtin_amdgcn_readfirstlane(tid >> 6), lane = tid & 63, wr = wid >> 2, wc = wid & 3, fr = lane & 15, fq = lane >> 4;
    const int K = g.K, nt = K / BK;
    int ts_lo = 0, ts_hi = 0, nts = 0; const unsigned long long rt_entry = STAMP ? (unsigned long long)wall_clock64() : 0ull;
#define PG8_STAMP() do { if (STAMP && wid == 0 && nts < 64) { const unsigned long long _c = (unsigned long long)clock64(); \
        ts_lo = (lane == nts) ? (int)(unsigned)_c : ts_lo; ts_hi = (lane == nts) ? (int)(unsigned)(_c >> 32) : ts_hi; ++nts; } } while (0)
    PG8_STAMP();
    unsigned voffA[2], voffB[2];
#pragma unroll
    for (int i = 0; i < 2; ++i) { int R, C; stage_rc(tid * 16 + i * 8192, R, C); const int Rb = Epi::PERM ? ((R & ~31) + perm32(R & 31)) : R;
        voffA[i] = (unsigned)(R * K + C) * 2u; voffB[i] = (unsigned)(Rb * K + C) * 2u; }
    const size_t kstep = (size_t)(BK * 2);
    const size_t hstep = (size_t)HALF * K * 2;
    const size_t tstep = 2 * hstep;
    const unsigned ldsw = (unsigned)wid * 1024u;
    const int aoff = lds_byte(wr * 64 + fr, fq * 8), boff = lds_byte(wc * 32 + fr, fq * 8);
#define PG8_SA(b, h) (((b) * 2 + (h)) * HTB)
#define PG8_SB(b, h) ((4 + (b) * 2 + (h)) * HTB)
#define PG8_STAGE(bufoff, gbase, voff) do { _Pragma("unroll") for (int _i = 0; _i < 2; ++_i) \
        __builtin_amdgcn_global_load_lds((const unsigned*)((const char*)(gbase) + (voff)[_i]), (PG8_LAS unsigned*)(lds + (bufoff) + ldsw + _i * 8192), 16, 0, 0); } while (0)
#define PG8_LDA(dst, b, h) do { _Pragma("unroll") for (int m = 0; m < 4; ++m) _Pragma("unroll") for (int k = 0; k < 2; ++k) dst[m][k] = *(const PG8_LAS bf16x8*)(lds + PG8_SA(b, h) + aoff + m * 2048 + k * 1024); } while (0)
#define PG8_LDB(dst, b, h) do { _Pragma("unroll") for (int n = 0; n < 2; ++n) _Pragma("unroll") for (int k = 0; k < 2; ++k) dst[n][k] = *(const PG8_LAS bf16x8*)(lds + PG8_SB(b, h) + boff + n * 2048 + k * 1024); } while (0)
#define PG8_MMA(ai, bj, At, Bt) do { __builtin_amdgcn_s_setprio(1); _Pragma("unroll") for (int m = 0; m < 4; ++m) _Pragma("unroll") for (int n = 0; n < 2; ++n) _Pragma("unroll") for (int k = 0; k < 2; ++k) \
        acc[ai][bj][m][n] = __builtin_amdgcn_mfma_f32_16x16x32_bf16(Bt[n][k], At[m][k], acc[ai][bj][m][n], 0, 0, 0); __builtin_amdgcn_s_setprio(0); } while (0)
#define PG8_WAIT_V(n) asm volatile("s_waitcnt vmcnt(" #n ")" ::: "memory")
#define PG8_WAIT_L(n) asm volatile("s_waitcnt lgkmcnt(" #n ")" ::: "memory")
#define PG8_BAR __builtin_amdgcn_s_barrier()
#define PG8_SCHED __builtin_amdgcn_sched_barrier(0)
    Unit cur, nxt; int ui = 0;
    if (!S.next(0, cur)) return;
    f32x4 acc[2][2][4][2];
#pragma unroll
    for (int a = 0; a < 2; ++a)
#pragma unroll
        for (int b = 0; b < 2; ++b)
#pragma unroll
            for (int m = 0; m < 4; ++m)
#pragma unroll
                for (int n = 0; n < 2; ++n) acc[a][b][m][n] = (f32x4){0.f, 0.f, 0.f, 0.f};
    bf16x8 At[4][2], B0[2][2], B1[2][2];
    const char* cA = (const char*)g.A + (size_t)cur.pm * tstep; const char* cB = (const char*)g.Bt + (size_t)cur.pn * tstep;
    S.a_ready(cur);
    PG8_STAGE(PG8_SB(0, 0), cB, voffB); PG8_STAGE(PG8_SA(0, 0), cA, voffA); PG8_STAGE(PG8_SB(0, 1), cB + hstep, voffB); PG8_STAGE(PG8_SA(0, 1), cA + hstep, voffA);
    if (wr == 1) PG8_BAR;
    PG8_WAIT_V(4); PG8_BAR;
    PG8_STAGE(PG8_SB(1, 0), cB + kstep, voffB); PG8_STAGE(PG8_SA(1, 0), cA + kstep, voffA); PG8_STAGE(PG8_SB(1, 1), cB + hstep + kstep, voffB);
    PG8_WAIT_V(6); PG8_BAR;
    PG8_STAMP();
    for (;;) {
        const bool has_next = S.next(ui + 1, nxt);
        const char* nA = has_next ? (const char*)g.A + (size_t)nxt.pm * tstep : cA; const char* nB = has_next ? (const char*)g.Bt + (size_t)nxt.pn * tstep : cB;
        for (int t = 0; t < nt; t += 2) {
            const bool last = (t == nt - 2);
            const char* a1 = cA + (size_t)(t + 1) * kstep;
            const char* a2 = last ? nA : cA + (size_t)(t + 2) * kstep; const char* b2 = last ? nB : cB + (size_t)(t + 2) * kstep;
            const char* a3 = a2 + kstep; const char* b3 = b2 + kstep;
            if (last && has_next) S.a_ready(nxt);
            PG8_LDB(B0, 0, 0); PG8_SCHED; PG8_LDA(At, 0, 0); PG8_STAGE(PG8_SA(1, 1), a1 + hstep, voffA);
            PG8_WAIT_L(8); PG8_BAR; PG8_WAIT_L(0); PG8_MMA(0, 0, At, B0); PG8_BAR; PG8_SCHED;
            PG8_LDB(B1, 0, 1); PG8_STAGE(PG8_SB(0, 0), b2, voffB);
            PG8_BAR; PG8_WAIT_L(0); PG8_MMA(0, 1, At, B1); PG8_BAR;
            PG8_LDA(At, 0, 1); PG8_STAGE(PG8_SA(0, 0), a2, voffA);
            PG8_BAR; PG8_WAIT_L(0); PG8_MMA(1, 0, At, B0); PG8_BAR; PG8_SCHED;
            PG8_STAGE(PG8_SB(0, 1), b2 + hstep, voffB);
            PG8_WAIT_V(6); PG8_BAR; PG8_MMA(1, 1, At, B1); PG8_BAR;
            PG8_LDB(B0, 1, 0); PG8_SCHED; PG8_LDA(At, 1, 0); PG8_STAGE(PG8_SA(0, 1), a2 + hstep, voffA);
            PG8_WAIT_L(8); PG8_BAR; PG8_WAIT_L(0); PG8_MMA(0, 0, At, B0); PG8_BAR; PG8_SCHED;
            PG8_LDB(B1, 1, 1); PG8_STAGE(PG8_SB(1, 0), b3, voffB);
            PG8_BAR; PG8_WAIT_L(0); PG8_MMA(0, 1, At, B1); PG8_BAR;
            PG8_LDA(At, 1, 1); PG8_STAGE(PG8_SA(1, 0), a3, voffA);
            PG8_BAR; PG8_WAIT_L(0); PG8_MMA(1, 0, At, B0); PG8_BAR; PG8_SCHED;
            PG8_STAGE(PG8_SB(1, 1), b3 + hstep, voffB);
            PG8_WAIT_V(6); PG8_BAR; PG8_MMA(1, 1, At, B1); PG8_BAR;
        }
        PG8_STAMP();
        if constexpr (!Epi::AFTER_DRAIN) { E(acc, cur, wr, wc, fr, fq); S.done(cur); }
        PG8_STAMP();
        if (!has_next) break;
#pragma unroll
        for (int a = 0; a < 2; ++a)
#pragma unroll
            for (int b = 0; b < 2; ++b)
#pragma unroll
                for (int m = 0; m < 4; ++m)
#pragma unroll
                    for (int n = 0; n < 2; ++n) acc[a][b][m][n] = (f32x4){0.f, 0.f, 0.f, 0.f};
        cur = nxt; cA = nA; cB = nB; ++ui;
    }
    PG8_WAIT_V(0);
    if (wr == 0) PG8_BAR;
    PG8_BAR;
    if constexpr (Epi::AFTER_DRAIN) { E.fused(acc, cur, wr, wc, fr, fq, lds, wid, lane); S.done(cur); }
    PG8_STAMP();
    if (STAMP && wid == 0) { stamps[lane] = lane < nts ? (((unsigned long long)(unsigned)ts_hi << 32) | (unsigned)ts_lo) : 0ull;
        if (lane == 62) stamps[62] = rt_entry; if (lane == 63) stamps[63] = (unsigned long long)wall_clock64(); }
#undef PG8_STAMP
#undef PG8_SA
#undef PG8_SB
#undef PG8_STAGE
#undef PG8_LDA
#undef PG8_LDB
#undef PG8_MMA
#undef PG8_WAIT_V
#undef PG8_WAIT_L
#undef PG8_BAR
#undef PG8_SCHED
}
}

namespace att {
using bf16 = __hip_bfloat16;
constexpr int D = 128, NW = 8, QBLK = 32, KVBLK = 64;
constexpr float SCALE = 0.088388347648318440f;
constexpr float THR = 8.f;
constexpr size_t SHM_V = KVBLK * D * 2, SHM_K = KVBLK * D * 2;
constexpr int LDK = NP;
using bf16x8 = __attribute__((ext_vector_type(8))) short;
using s16x4  = __attribute__((ext_vector_type(4))) short;
using f32x16 = __attribute__((ext_vector_type(16))) float;
using f32x8  = __attribute__((ext_vector_type(8))) float;
using u32x4  = __attribute__((ext_vector_type(4))) unsigned;
#define KSWZ(row, colB) ((row) * 256 + ((colB) ^ (((row) & 7) << 4)))
#define SBAR() __builtin_amdgcn_sched_barrier(0)
__device__ __forceinline__ int crow(int r, int hi) { return (r & 3) + 8 * (r >> 2) + 4 * hi; }
__device__ __forceinline__ unsigned cvtpk(float lo, float hi) {
  unsigned r; asm volatile("v_cvt_pk_bf16_f32 %0, %1, %2" : "=v"(r) : "v"(lo), "v"(hi)); return r;
}
template <typename TIn> struct Stage;
template <> struct Stage<bf16>  { using T = bf16x8;
  __device__ static __forceinline__ T ld8(const bf16* p) { return *reinterpret_cast<const bf16x8*>(p); }
  __device__ static __forceinline__ bf16x8 tobf(T x) { return x; } };
template <> struct Stage<float> { using T = f32x8;
  __device__ static __forceinline__ T ld8(const float* p) { return *reinterpret_cast<const f32x8*>(p); }
  __device__ static __forceinline__ bf16x8 tobf(T x) {
    u32x4 w = {cvtpk(x[0], x[1]), cvtpk(x[2], x[3]), cvtpk(x[4], x[5]), cvtpk(x[6], x[7])}; return *reinterpret_cast<bf16x8*>(&w); } };

__device__ __forceinline__ void partialSM(f32x16& p0, f32x16& p1, float& m_reg, float& mn, float& alpha) {
  constexpr float C = SCALE * 1.4426950408889634f;
  float pmax = p0[0]; for (int r = 1; r < 16; ++r) pmax = fmaxf(pmax, p0[r]); for (int r = 0; r < 16; ++r) pmax = fmaxf(pmax, p1[r]);
  { auto rr = __builtin_amdgcn_permlane32_swap(__float_as_uint(pmax), __float_as_uint(pmax), false, false);
    pmax = fmaxf(__uint_as_float(rr[0]), __uint_as_float(rr[1])); }
  if (__builtin_expect(__all(pmax - m_reg <= THR / SCALE), 1)) { mn = m_reg; alpha = 1.f; }
  else { mn = fmaxf(m_reg, pmax); alpha = __builtin_amdgcn_exp2f((m_reg - mn) * C); m_reg = mn; }
  float mnC = -mn * C;
  for (int r = 0; r < 16; ++r) p0[r] = fmaf(p0[r], C, mnC); for (int r = 0; r < 16; ++r) p1[r] = fmaf(p1[r], C, mnC);
  for (int r = 0; r < 16; ++r) p0[r] = __builtin_amdgcn_exp2f(p0[r]);
}
__device__ __forceinline__ void finishSM(f32x16& p0, f32x16& p1, float alpha, float& l_reg, bf16x8& pa0, bf16x8& pa1, bf16x8& pa2, bf16x8& pa3) {
  for (int r = 0; r < 16; ++r) p1[r] = __builtin_amdgcn_exp2f(p1[r]);
  float ps = 0; for (int r = 0; r < 16; ++r) ps += p0[r]; for (int r = 0; r < 16; ++r) ps += p1[r];
  { auto rr = __builtin_amdgcn_permlane32_swap(__float_as_uint(ps), __float_as_uint(ps), false, false);
    ps = __uint_as_float(rr[0]) + __uint_as_float(rr[1]); }
  l_reg = l_reg * alpha + ps;
#define PK4(P, BASE, OUT) do { unsigned a0 = cvtpk(P[BASE + 0], P[BASE + 1]), a1 = cvtpk(P[BASE + 2], P[BASE + 3]);   \
    unsigned b0 = cvtpk(P[BASE + 4], P[BASE + 5]), b1 = cvtpk(P[BASE + 6], P[BASE + 7]);                              \
    auto r0 = __builtin_amdgcn_permlane32_swap(a0, b0, false, false); auto r1 = __builtin_amdgcn_permlane32_swap(a1, b1, false, false); \
    u32x4 w = {r0[0], r1[0], r0[1], r1[1]}; OUT = *reinterpret_cast<bf16x8*>(&w); } while (0)
  PK4(p0, 0, pa0); PK4(p0, 8, pa1); PK4(p1, 0, pa2); PK4(p1, 8, pa3);
#undef PK4
}
__device__ __forceinline__ void qkt(f32x16& p0, f32x16& p1, const bf16* Ks, const bf16x8* qr, int r32, int hi) {
  p0 = f32x16{}; p1 = f32x16{};
  for (int d0 = 0; d0 < 8; ++d0) { int cb = (d0 * 16 + hi * 8) * 2;
    bf16x8 b0 = *reinterpret_cast<const bf16x8*>((const char*)Ks + KSWZ(r32, cb));
    bf16x8 b1 = *reinterpret_cast<const bf16x8*>((const char*)Ks + KSWZ(32 + r32, cb));
    p0 = __builtin_amdgcn_mfma_f32_32x32x16_bf16(b0, qr[d0], p0, 0, 0, 0);
    p1 = __builtin_amdgcn_mfma_f32_32x32x16_bf16(b1, qr[d0], p1, 0, 0, 0); }
}
__device__ __forceinline__ int v_st(int k, int c) { const int kk = (k & ~0xC) | ((k & 4) << 1) | ((k & 8) >> 1); return ((kk >> 3) * 4 + (c >> 5)) * 512 + ((kk & 7) * 32 + (c & 31)) * 2; }
__device__ __forceinline__ int v_rd_base(int lane) { return ((lane & 3) << 3) | (((lane >> 2) & 3) << 6) | (((lane >> 4) & 1) << 5) | (((lane >> 5) & 1) << 8); }
constexpr int v_rd_off(int d0, int ks, int half) { return d0 * 512 + ks * 4096 + half * 2048; }
template <int OFF> __device__ __forceinline__ s16x4 tr_read(int vb) {
  s16x4 r; asm volatile("ds_read_b64_tr_b16 %0, %1 offset:%2" : "=&v"(r) : "v"(vb), "i"(OFF) : "memory"); return r;
}
template <int D0> __device__ __forceinline__ void pv_one(f32x16& od, int vb, bf16x8 pa0, bf16x8 pa1, bf16x8 pa2, bf16x8 pa3) {
  const s16x4 l0 = tr_read<v_rd_off(D0, 0, 0)>(vb), h0 = tr_read<v_rd_off(D0, 0, 1)>(vb), l1 = tr_read<v_rd_off(D0, 1, 0)>(vb), h1 = tr_read<v_rd_off(D0, 1, 1)>(vb);
  const s16x4 l2 = tr_read<v_rd_off(D0, 2, 0)>(vb), h2 = tr_read<v_rd_off(D0, 2, 1)>(vb), l3 = tr_read<v_rd_off(D0, 3, 0)>(vb), h3 = tr_read<v_rd_off(D0, 3, 1)>(vb);
  asm volatile("s_waitcnt lgkmcnt(0)" ::: "memory"); SBAR();
#define PK(L, H) (bf16x8){L[0], L[1], L[2], L[3], H[0], H[1], H[2], H[3]}
  od = __builtin_amdgcn_mfma_f32_32x32x16_bf16(pa0, PK(l0, h0), od, 0, 0, 0);
  od = __builtin_amdgcn_mfma_f32_32x32x16_bf16(pa1, PK(l1, h1), od, 0, 0, 0);
  od = __builtin_amdgcn_mfma_f32_32x32x16_bf16(pa2, PK(l2, h2), od, 0, 0, 0);
  od = __builtin_amdgcn_mfma_f32_32x32x16_bf16(pa3, PK(l3, h3), od, 0, 0, 0);
#undef PK
}
__device__ __forceinline__ void pv_d0(f32x16* o, int vb, bf16x8 pa0, bf16x8 pa1, bf16x8 pa2, bf16x8 pa3) {
  pv_one<0>(o[0], vb, pa0, pa1, pa2, pa3); pv_one<1>(o[1], vb, pa0, pa1, pa2, pa3); pv_one<2>(o[2], vb, pa0, pa1, pa2, pa3); pv_one<3>(o[3], vb, pa0, pa1, pa2, pa3);
}

template <int MODE>
__device__ __forceinline__ void attn_item(const Params& p, int l, int b, int h, int qt, char* lds) {
  using St = Stage<bf16>;
  const int tid = tidx(), wid = tid >> 6, lane = tid & 63, r32 = lane & 31, hi = lane >> 5;
  const bool isLat = qt < 8;
  const int q0 = isLat ? qt * 256 : 0;
  const int qrow0 = b * TPB + (isLat ? CTXL + q0 : 0);
  const int kvh = h >> 2;
  constexpr int QCOL = MODE == 0 ? COL_AQ : COL_BQ, KCOL = MODE == 0 ? COL_AK : COL_BK, VCOL = MODE == 0 ? COL_AV : COL_BV, ZCOL = MODE == 0 ? COL_AZ : COL_BZ;
  int NT, wtok;
  if (!isLat) { NT = 4; wtok = CTXL; }
  else if (MODE == 1) { NT = 36; wtok = CTXL; }
  else { const int lo = q0 - 128 < 0 ? 0 : q0 - 128, hi_ = q0 + 384 > SEQ ? SEQ : q0 + 384; wtok = CTXL + lo; NT = 4 + (hi_ - lo) / 64; }
  const bf16* Kh = (const bf16*)(p.proj + (size_t)b * TPB * NP + KCOL + kvh * 128);
  const bf16* Vh = (const bf16*)(p.proj + (size_t)b * TPB * NP + VCOL + kvh * 128);
#define KT(j) ((j) < 4 ? (j) * 64 : wtok + ((j) - 4) * 64)
  bf16* V_lds = (bf16*)lds; bf16* K_lds = (bf16*)(lds + 2 * SHM_V);
  float* ws = (float*)(lds + 2 * SHM_V + 2 * SHM_K) + wid * 64; float* li_l = ws; float* al_l = ws + 32;
  float m_reg = -1e30f, l_reg = 0; f32x16 o[4] = {}; bf16x8 qr[8];
  {
    const bf16_t* Qw = p.proj + (size_t)(qrow0 + wid * QBLK + r32) * NP + QCOL + h * 128 + hi * 8;
    float xf[8][8];
#pragma unroll
    for (int d0 = 0; d0 < 8; ++d0) { const bf16x8 raw = *reinterpret_cast<const bf16x8*>(Qw + d0 * 16);
#pragma unroll
      for (int j = 0; j < 8; ++j) xf[d0][j] = bf2f((bf16_t)raw[j]); }
    if (MODE == 1) {
      float ss = 0.f;
#pragma unroll
      for (int d0 = 0; d0 < 8; ++d0)
#pragma unroll
        for (int j = 0; j < 8; ++j) ss += xf[d0][j] * xf[d0][j];
      ss += __shfl_xor(ss, 32);
      const float rstd = rsqrtf(ss * (1.f / 128.f) + 1e-6f);
      const float* qn = p.b_qn + l * 128 + hi * 8;
#pragma unroll
      for (int d0 = 0; d0 < 8; ++d0) { const float4 g0 = *(const float4*)(qn + d0 * 16), g1 = *(const float4*)(qn + d0 * 16 + 4);
        xf[d0][0] *= rstd * g0.x; xf[d0][1] *= rstd * g0.y; xf[d0][2] *= rstd * g0.z; xf[d0][3] *= rstd * g0.w;
        xf[d0][4] *= rstd * g1.x; xf[d0][5] *= rstd * g1.y; xf[d0][6] *= rstd * g1.z; xf[d0][7] *= rstd * g1.w; }
    }
    if (isLat) {
      const int pos = q0 + wid * QBLK + r32;
      const float* ct = p.cos_t + pos * 64 + hi * 8; const float* st = p.sin_t + pos * 64 + hi * 8;
#pragma unroll
      for (int d0 = 0; d0 < 4; ++d0) {
        const float4 c0 = *(const float4*)(ct + d0 * 16), c1 = *(const float4*)(ct + d0 * 16 + 4), s0 = *(const float4*)(st + d0 * 16), s1 = *(const float4*)(st + d0 * 16 + 4);
        const float cc[8] = {c0.x, c0.y, c0.z, c0.w, c1.x, c1.y, c1.z, c1.w}, sn[8] = {s0.x, s0.y, s0.z, s0.w, s1.x, s1.y, s1.z, s1.w};
#pragma unroll
        for (int j = 0; j < 8; ++j) { const float x1 = xf[d0][j], x2 = xf[d0 + 4][j]; xf[d0][j] = x1 * cc[j] - x2 * sn[j]; xf[d0 + 4][j] = x2 * cc[j] + x1 * sn[j]; }
      }
    }
#pragma unroll
    for (int d0 = 0; d0 < 8; ++d0) { u32x4 w = {cvtpk(xf[d0][0], xf[d0][1]), cvtpk(xf[d0][2], xf[d0][3]), cvtpk(xf[d0][4], xf[d0][5]), cvtpk(xf[d0][6], xf[d0][7])}; qr[d0] = *reinterpret_cast<bf16x8*>(&w); }
  }
  const int sr = tid >> 4, sc = (tid & 15) * 8, vst0 = v_st(sr, sc), vst1 = v_st(32 + sr, sc);
  const int vb0 = (int)(uintptr_t)V_lds + v_rd_base(lane);
  struct { typename St::T vs0, vs1, ks0, ks1; } sr_[2];
#define SLOAD(i, k0) do { const int k0_ = (k0); sr_[i].vs0 = St::ld8(&Vh[(long)(k0_ + sr) * LDK + sc]); sr_[i].vs1 = St::ld8(&Vh[(long)(k0_ + 32 + sr) * LDK + sc]); \
    sr_[i].ks0 = St::ld8(&Kh[(long)(k0_ + sr) * LDK + sc]); sr_[i].ks1 = St::ld8(&Kh[(long)(k0_ + 32 + sr) * LDK + sc]); } while (0)
#define SWRITE(b, i) do { *(bf16x8*)((char*)V_lds + (b) * SHM_V + vst0) = St::tobf(sr_[i].vs0);          \
    *(bf16x8*)((char*)V_lds + (b) * SHM_V + vst1) = St::tobf(sr_[i].vs1); int kc = sc * 2;               \
    *(bf16x8*)((char*)K_lds + (b) * SHM_K + KSWZ(sr, kc)) = St::tobf(sr_[i].ks0);                       \
    *(bf16x8*)((char*)K_lds + (b) * SHM_K + KSWZ(32 + sr, kc)) = St::tobf(sr_[i].ks1); } while (0)
#define SWAIT() asm volatile("s_waitcnt vmcnt(4)" ::: "memory")
#define RESC(a) do { if (__any((a) < 1.f)) { if (hi == 0) al_l[r32] = (a); asm volatile("s_waitcnt lgkmcnt(0)" ::: "memory"); \
    _Pragma("unroll") for (int d = 0; d < 4; ++d) _Pragma("unroll") for (int r = 0; r < 16; ++r) o[d][r] *= al_l[crow(r, hi)]; } } while (0)
#define MASK(P0, P1, j) do { if (MODE == 0 && isLat && (j) >= 4) { const int dq_ = (q0 + wid * QBLK + r32) - (KT(j) - CTXL); \
    _Pragma("unroll") for (int r = 0; r < 16; ++r) { const int e0_ = dq_ - crow(r, hi), e1_ = e0_ - 32; \
      if (e0_ > 128 || e0_ < -128) P0[r] = -1e30f; if (e1_ > 128 || e1_ < -128) P1[r] = -1e30f; } } } while (0)
  f32x16 pA0, pA1, pB0, pB1; float mnA, mnB, alA, alB; bf16x8 pa0, pa1, pa2, pa3;
  constexpr int SE = 0, SO = 1;
  SLOAD(SE, KT(0)); asm volatile("s_waitcnt vmcnt(0)" ::: "memory"); SWRITE(0, SE); __syncthreads();
  qkt(pA0, pA1, K_lds, qr, r32, hi); partialSM(pA0, pA1, m_reg, mnA, alA);
  SLOAD(SO, KT(1)); if (2 < NT) SLOAD(SE, KT(2));
  SWAIT(); SWRITE(1, SO); __syncthreads();
  for (int j = 1; j + 1 < NT; j += 2) {
    SBAR(); qkt(pB0, pB1, (bf16*)((char*)K_lds + SHM_K), qr, r32, hi); MASK(pB0, pB1, j);
    finishSM(pA0, pA1, alA, l_reg, pa0, pa1, pa2, pa3); SBAR();
    SLOAD(SO, KT(j + 2)); SBAR();
    pv_d0(o, vb0, pa0, pa1, pa2, pa3); partialSM(pB0, pB1, m_reg, mnB, alB);
    __syncthreads(); SWAIT(); SWRITE(0, SE);
    RESC(alB); __syncthreads();
    SBAR(); qkt(pA0, pA1, K_lds, qr, r32, hi); MASK(pA0, pA1, j + 1);
    finishSM(pB0, pB1, alB, l_reg, pa0, pa1, pa2, pa3); SBAR();
    if (j + 3 < NT) SLOAD(SE, KT(j + 3)); SBAR();
    pv_d0(o, vb0 + (int)SHM_V, pa0, pa1, pa2, pa3); partialSM(pA0, pA1, m_reg, mnA, alA);
    __syncthreads(); SWAIT(); SWRITE(1, SO);
    RESC(alA); __syncthreads();
  }
  SBAR(); qkt(pB0, pB1, (bf16*)((char*)K_lds + SHM_K), qr, r32, hi); MASK(pB0, pB1, NT - 1);
  finishSM(pA0, pA1, alA, l_reg, pa0, pa1, pa2, pa3); SBAR();
  pv_d0(o, vb0, pa0, pa1, pa2, pa3); partialSM(pB0, pB1, m_reg, mnB, alB);
  __syncthreads(); RESC(alB);
  finishSM(pB0, pB1, alB, l_reg, pa0, pa1, pa2, pa3); SBAR();
  pv_d0(o, vb0 + (int)SHM_V, pa0, pa1, pa2, pa3);
  if (MODE == 0) { constexpr float C = SCALE * 1.4426950408889634f; l_reg += __builtin_amdgcn_exp2f(p.a_sink[l * 8 + h] * 1.4426950408889634f - m_reg * C); }
  if (hi == 0) li_l[r32] = l_reg; asm volatile("s_waitcnt lgkmcnt(0)" ::: "memory");
  float rli[16];
#pragma unroll
  for (int r = 0; r < 16; ++r) rli[r] = __builtin_amdgcn_rcpf(li_l[crow(r, hi)]);
  bf16_t* Og = p.gin + (size_t)MODE * TT * 1024 + (size_t)(qrow0 + wid * QBLK) * 1024 + h * 128 + r32;
  const bf16_t* Zg = p.proj + (size_t)(qrow0 + wid * QBLK) * NP + ZCOL + h * 128 + r32;
#pragma unroll
  for (int r = 0; r < 16; ++r) { const int orow = crow(r, hi);
#pragma unroll
    for (int d0 = 0; d0 < 4; ++d0) { const float z = bf2f(Zg[(size_t)orow * NP + d0 * 32]); Og[(size_t)orow * 1024 + d0 * 32] = f2bf(o[d0][r] * rli[r] * siluf_(z)); } }
  __syncthreads();
#undef KT
#undef SLOAD
#undef SWRITE
#undef SWAIT
#undef RESC
#undef MASK
}
}

namespace hg {
using att::bf16x8; using att::f32x16; using att::crow;
typedef unsigned u32x2 __attribute__((ext_vector_type(2)));
typedef unsigned u32x4_ __attribute__((ext_vector_type(4)));
constexpr int RS = 272, RS2 = 144;
constexpr int O_QD = 0, O_KD = O_QD + 64 * RS, O_QO = O_KD + 64 * RS, O_KO = O_QO + 32 * RS, O_QS = O_KO + 32 * RS, O_KST = O_QS + 64 * RS, O_VT = O_KST + 128 * RS2,
              O_P = O_VT + 64 * RS2, O_SBT = O_P + 64 * RS2, O_SEG = O_SBT + 64 * RS, O_ETOT = O_SEG + 2048, O_END = O_ETOT + 512;
static_assert(O_END <= LDS_BYTES, "hgrn LDS");
__device__ __forceinline__ bf16x8 ldf(const unsigned char* base, int row, int rs, int kk, int hi) { return *reinterpret_cast<const bf16x8*>(base + row * rs + (kk * 16 + hi * 8) * 2); }

__device__ __forceinline__ void hgrn_item(const Params& p, int l, int item, unsigned char* lds) {
  const int tid = tidx(), w = tid >> 6, lane = tid & 63, r32 = lane & 31, hi = lane >> 5;
  const int vh = item & 1, dir = (item >> 1) & 1, h = (item >> 2) & 7, b = item >> 5;
  const int kh = w & 1, seg = w >> 1, k = kh * 64 + lane;
  const bf16_t* projb = p.proj + (size_t)b * TPB * NP;
  const int qcol = COL_CQ + h * 128 + k, zcol = (dir ? COL_CZB : COL_CZF) + h * 128 + k, vcol = COL_CI + h * 128 + vh * 64;
  const float lbk = p.lbv[(l * 2 + dir) * 1024 + h * 128 + k], oml = 1.f - lbk;
  const int vs = tid >> 3, vc = (tid & 7) * 8;
  unsigned char* Qd = lds + O_QD; unsigned char* Kd = lds + O_KD; unsigned char* Qo = lds + O_QO; unsigned char* Ko = lds + O_KO; unsigned char* Qs = lds + O_QS;
  unsigned char* KsT = lds + O_KST; unsigned char* VT = lds + O_VT; unsigned char* P = lds + O_P; unsigned char* SbT = lds + O_SBT;
  float* segtot = (float*)(lds + O_SEG); float* etot = (float*)(lds + O_ETOT);
  for (int i = tid; i < 64 * RS / 4; i += 512) ((unsigned*)SbT)[i] = 0u;
  f32x16 Sacc = {};
  const int sgn = dir ? -1 : 1;
  bf16_t zr[16], qg[16]; bf16x8 vr;
  float* od = p.pbuf + (size_t)dir * TT * 1024 + (size_t)b * TPB * 1024 + h * 128 + vh * 64;
#define CHBASE(c) (dir ? ((c) < 4 ? 255 - 64 * (c) : 2303 - 64 * ((c) - 4)) : 64 * (c))
#define LOADCH(c) do { const int pb_ = CHBASE(c); \
    _Pragma("unroll") for (int i = 0; i < 16; ++i) { const bf16_t* rp_ = projb + (size_t)(pb_ + sgn * (16 * seg + i)) * NP; zr[i] = rp_[zcol]; qg[i] = rp_[qcol]; } \
    vr = *reinterpret_cast<const bf16x8*>(projb + (size_t)(pb_ + sgn * vs) * NP + vcol + vc); } while (0)
  LOADCH(0);
  for (int c = 0; c < 36; ++c) {
    const int pbase = CHBASE(c);
    float cum[16], kk[16], qf[16];
    { float run = 0.f;
#pragma unroll
      for (int i = 0; i < 16; ++i) { const float z = bf2f(zr[i]); const float e = __expf(-z); const float sg = 1.f / (1.f + e);
        run += __logf(lbk + oml * sg); cum[i] = run; kk[i] = oml * e * sg; qf[i] = bf2f(qg[i]) * 0.088388347648318440f; }
    }
    segtot[seg * 128 + k] = cum[15];
    __syncthreads();
    const float t0 = segtot[k], t1 = segtot[128 + k], t2 = segtot[256 + k], t3 = segtot[384 + k];
    const float c15 = t0, c31 = t0 + t1, c47 = c31 + t2, tot = c47 + t3;
    const float pre = seg == 0 ? 0.f : (seg == 1 ? c15 : (seg == 2 ? c31 : c47));
    const float refd = seg < 2 ? c15 : c47;
    if (seg == 0) etot[k] = __expf(tot);
    { float ksv[16];
#pragma unroll
      for (int i = 0; i < 16; ++i) { const float cu = cum[i] + pre; const int t = 16 * seg + i;
        const float ed = __expf(fminf(cu - refd, 80.f)), edi = __expf(fminf(refd - cu, 80.f));
        ((bf16_t*)Qd)[t * (RS / 2) + k] = f2bf(qf[i] * ed); ((bf16_t*)Kd)[t * (RS / 2) + k] = f2bf(kk[i] * edi);
        if (seg >= 2) ((bf16_t*)Qo)[(t - 32) * (RS / 2) + k] = f2bf(qf[i] * __expf(cu - c31));
        else          ((bf16_t*)Ko)[t * (RS / 2) + k] = f2bf(kk[i] * __expf(c31 - cu));
        ((bf16_t*)Qs)[t * (RS / 2) + k] = f2bf(qf[i] * __expf(cu));
        ksv[i] = kk[i] * __expf(tot - cu); }
      const u32x4_ w0 = {cvtpk2(ksv[0], ksv[1]), cvtpk2(ksv[2], ksv[3]), cvtpk2(ksv[4], ksv[5]), cvtpk2(ksv[6], ksv[7])};
      const u32x4_ w1 = {cvtpk2(ksv[8], ksv[9]), cvtpk2(ksv[10], ksv[11]), cvtpk2(ksv[12], ksv[13]), cvtpk2(ksv[14], ksv[15])};
      *reinterpret_cast<u32x4_*>(KsT + k * RS2 + seg * 32) = w0; *reinterpret_cast<u32x4_*>(KsT + k * RS2 + seg * 32 + 16) = w1; }
#pragma unroll
    for (int j = 0; j < 8; ++j) ((bf16_t*)VT)[(vc + j) * (RS2 / 2) + vs] = (bf16_t)vr[j];
    if (c + 1 < 36) LOADCH(c + 1);
    __syncthreads();
    f32x16 oacc = {};
    const int tb = (w - 4) >> 1, vb = (w - 4) & 1;
    if (w < 3) {
      const unsigned char* Asrc = w == 2 ? Ko : Kd + (32 * w) * RS; const unsigned char* Bsrc = w == 2 ? Qo : Qd + (32 * w) * RS;
      f32x16 acc = {};
#pragma unroll
      for (int q = 0; q < 8; ++q) acc = __builtin_amdgcn_mfma_f32_32x32x16_bf16(ldf(Asrc, r32, RS, q, hi), ldf(Bsrc, r32, RS, q, hi), acc, 0, 0, 0);
      const int trow = (w == 0 ? 0 : 32) + r32, scol0 = (w == 1 ? 32 : 0);
#pragma unroll
      for (int g = 0; g < 4; ++g) { const int s0 = 8 * g + 4 * hi; float v0 = acc[4 * g], v1 = acc[4 * g + 1], v2 = acc[4 * g + 2], v3 = acc[4 * g + 3];
        if (w < 2) { v0 = (s0 <= r32) ? v0 : 0.f; v1 = (s0 + 1 <= r32) ? v1 : 0.f; v2 = (s0 + 2 <= r32) ? v2 : 0.f; v3 = (s0 + 3 <= r32) ? v3 : 0.f; }
        u32x2 pk = {cvtpk2(v0, v1), cvtpk2(v2, v3)}; *reinterpret_cast<u32x2*>(P + trow * RS2 + (scol0 + s0) * 2) = pk; }
    } else if (w >= 4) {
#pragma unroll
      for (int q = 0; q < 8; ++q) oacc = __builtin_amdgcn_mfma_f32_32x32x16_bf16(ldf(Qs, 32 * tb + r32, RS, q, hi), ldf(SbT, 32 * vb + r32, RS, q, hi), oacc, 0, 0, 0);
    }
    __syncthreads();
    if (w >= 4) {
      const int nks = tb == 0 ? 2 : 4;
      for (int q = 0; q < nks; ++q) oacc = __builtin_amdgcn_mfma_f32_32x32x16_bf16(ldf(P, 32 * tb + r32, RS2, q, hi), ldf(VT, 32 * vb + r32, RS2, q, hi), oacc, 0, 0, 0);
#pragma unroll
      for (int r = 0; r < 16; ++r) { const int t = 32 * tb + crow(r, hi); od[(size_t)(pbase + sgn * t) * 1024 + 32 * vb + r32] = oacc[r]; }
    }
    { const int kb = w >> 1, vb2 = w & 1;
#pragma unroll
      for (int r = 0; r < 16; ++r) Sacc[r] *= etot[32 * kb + crow(r, hi)];
#pragma unroll
      for (int q = 0; q < 4; ++q) Sacc = __builtin_amdgcn_mfma_f32_32x32x16_bf16(ldf(KsT, 32 * kb + r32, RS2, q, hi), ldf(VT, 32 * vb2 + r32, RS2, q, hi), Sacc, 0, 0, 0);
#pragma unroll
      for (int g = 0; g < 4; ++g) { u32x2 pk = {cvtpk2(Sacc[4 * g], Sacc[4 * g + 1]), cvtpk2(Sacc[4 * g + 2], Sacc[4 * g + 3])};
        *reinterpret_cast<u32x2*>(SbT + (32 * vb2 + r32) * RS + (32 * kb + 8 * g + 4 * hi) * 2) = pk; } }
    __syncthreads();
  }
#undef CHBASE
#undef LOADCH
}
}

struct Order {
    int nM, nN, nwg, G, c, rep, skipctx;
    __device__ void init(int nM_, int nN_, int rep_, int skipctx_, int G_, int c_) { nM = nM_; nN = nN_; nwg = nM * nN; G = G_; c = c_; rep = rep_; skipctx = skipctx_; }
    __device__ bool next(int i, pg8::Unit& u) const {
        const int tr = rep == 3 ? i / 3 : i, xb = rep == 3 ? i - 3 * tr : 0;
        const long L = (long)tr * G + c; if (L >= nwg) return false;
        int wgid = (int)L; { const int q = nwg / pg8::NXCD, r = nwg % pg8::NXCD, xcd = wgid % pg8::NXCD, off = wgid / pg8::NXCD; wgid = (xcd < r ? xcd * (q + 1) : r * (q + 1) + (xcd - r) * q) + off; }
        const int nig = pg8::WGM * nN, gid = wgid / nig, fm = gid * pg8::WGM, gsz = (nM - fm) < pg8::WGM ? (nM - fm) : pg8::WGM;
        int pm = fm + ((wgid % nig) % gsz); const int pn = (wgid % nig) / gsz;
        if (skipctx) pm = pm + pm / 8 + 1;
        u.pm = pm + 72 * xb; u.pn = pn + 8 * xb; return true;
    }
    __device__ __forceinline__ void a_ready(const pg8::Unit&) const {}
    __device__ __forceinline__ void done(const pg8::Unit&) const {}
};
typedef float f32x4_ __attribute__((ext_vector_type(4)));
typedef unsigned u32x4_ __attribute__((ext_vector_type(4)));
typedef short s16x8_ __attribute__((ext_vector_type(8)));
struct EpiProj {
    static constexpr bool PERM = true, AFTER_DRAIN = false;
    bf16_t* O;
    __device__ __forceinline__ void operator()(const pg8::f32x4 (&acc)[2][2][4][2], const pg8::Unit& u, int wr, int wc, int fr, int fq) const {
        const int row0 = u.pm * 256 + wr * 64 + fr, col0 = u.pn * 256 + wc * 32 + 8 * fq;
#pragma unroll
        for (int ai = 0; ai < 2; ++ai)
#pragma unroll
            for (int m = 0; m < 4; ++m) { bf16_t* rowp = O + (size_t)(row0 + ai * 128 + m * 16) * NP + col0;
#pragma unroll
                for (int bj = 0; bj < 2; ++bj) { const pg8::f32x4 v0 = acc[ai][bj][m][0], v1 = acc[ai][bj][m][1];
                    const u32x4_ w = {cvtpk2(v0[0], v0[1]), cvtpk2(v0[2], v0[3]), cvtpk2(v1[0], v1[1]), cvtpk2(v1[2], v1[3])};
                    *reinterpret_cast<u32x4_*>(rowp + bj * 128) = w; } }
    }
};
struct EpiBranch {
    static constexpr bool PERM = true, AFTER_DRAIN = false;
    const bf16_t* proj; float* pbuf; bf16_t* merged;
    __device__ __forceinline__ void operator()(const pg8::f32x4 (&acc)[2][2][4][2], const pg8::Unit& u, int wr, int wc, int fr, int fq) const {
        const int xb = u.pn >> 3, pn = u.pn & 7, pm = u.pm - 72 * xb;
        const int row0 = pm * 256 + wr * 64 + fr, col0 = pn * 256 + wc * 32 + 8 * fq;
#pragma unroll
        for (int ai = 0; ai < 2; ++ai)
#pragma unroll
            for (int m = 0; m < 4; ++m) { const size_t row = (size_t)(row0 + ai * 128 + m * 16);
#pragma unroll
                for (int bj = 0; bj < 2; ++bj) { const int col = col0 + bj * 128;
                    const s16x8_ gz = *reinterpret_cast<const s16x8_*>(proj + row * NP + COL_GATE + xb * 2048 + col);
                    const pg8::f32x4 v0 = acc[ai][bj][m][0], v1 = acc[ai][bj][m][1];
                    f32x4_ r0, r1;
#pragma unroll
                    for (int j = 0; j < 4; ++j) { r0[j] = v0[j] * sigmoidf_(bf2f((bf16_t)gz[j])); r1[j] = v1[j] * sigmoidf_(bf2f((bf16_t)gz[4 + j])); }
                    float* pp = pbuf + row * DM + col;
                    if (xb != 0) { r0 += *reinterpret_cast<const f32x4_*>(pp); r1 += *reinterpret_cast<const f32x4_*>(pp + 4); }
                    if (xb != 2) { *reinterpret_cast<f32x4_*>(pp) = r0; *reinterpret_cast<f32x4_*>(pp + 4) = r1; }
                    else { const u32x4_ w = {cvtpk2(r0[0], r0[1]), cvtpk2(r0[2], r0[3]), cvtpk2(r1[0], r1[1]), cvtpk2(r1[2], r1[3])};
                        *reinterpret_cast<u32x4_*>(merged + row * DM + col) = w; } } }
    }
};
struct EpiOut {
    static constexpr bool PERM = true, AFTER_DRAIN = false;
    const float* x; const float* ctx; float* resid; const float* modl; int layer0;
    __device__ __forceinline__ void operator()(const pg8::f32x4 (&acc)[2][2][4][2], const pg8::Unit& u, int wr, int wc, int fr, int fq) const {
        const int pm = u.pm, b = pm / 9, pc = pm - 9 * b;
        const int rin0 = wr * 64 + fr, col0 = u.pn * 256 + wc * 32 + 8 * fq;
        const float* gt = modl + (size_t)(pc == 0 ? 8 : b) * 6144 + 4096;
        const float* srcp = layer0 ? (pc == 0 ? ctx + (size_t)b * CTXL * DM : x + ((size_t)b * SEQ + (pc - 1) * 256) * DM) : resid + (size_t)pm * 256 * DM;
        float* dstp = resid + (size_t)pm * 256 * DM;
#pragma unroll
        for (int bj = 0; bj < 2; ++bj) { const int col = col0 + bj * 128;
            const f32x4_ g0 = *reinterpret_cast<const f32x4_*>(gt + col), g1 = *reinterpret_cast<const f32x4_*>(gt + col + 4);
#pragma unroll
            for (int ai = 0; ai < 2; ++ai)
#pragma unroll
                for (int m = 0; m < 4; ++m) { const size_t ro = (size_t)(rin0 + ai * 128 + m * 16) * DM + col;
                    const f32x4_ s0 = *reinterpret_cast<const f32x4_*>(srcp + ro), s1 = *reinterpret_cast<const f32x4_*>(srcp + ro + 4);
                    const pg8::f32x4 v0 = acc[ai][bj][m][0], v1 = acc[ai][bj][m][1];
                    f32x4_ r0, r1;
#pragma unroll
                    for (int j = 0; j < 4; ++j) { r0[j] = s0[j] + g0[j] * v0[j]; r1[j] = s1[j] + g1[j] * v1[j]; }
                    *reinterpret_cast<f32x4_*>(dstp + ro) = r0; *reinterpret_cast<f32x4_*>(dstp + ro + 4) = r1; } }
    }
};

__device__ __forceinline__ void ph_prologue(const Params& p, unsigned char* lds) {
    const int tid = tidx(), G = gridDim.x, wg = blockIdx.x, w = tid >> 6, lane = tid & 63;
    if (wg < 192) {
        float* sc = (float*)lds; float* red = sc + 9 * 2048;
        for (int i = tid; i < 9 * 2048; i += 512) { const int r = i >> 11, k = i & 2047; const float v = r < 8 ? p.c[r * 2048 + k] : p.c_ctx[k]; sc[i] = siluf_(v); }
        __syncthreads();
        for (int item = wg; item < 192; item += G) {
            const int l = item / 48, n0 = (item - l * 48) * 128;
            const float* wp = p.ada_w + ((size_t)l * 2048 + w * 256) * 6144 + n0 + lane * 2;
            const float* sp = sc + w * 256;
            float a0[9], a1[9];
#pragma unroll
            for (int r = 0; r < 9; ++r) { a0[r] = 0.f; a1[r] = 0.f; }
#pragma unroll 8
            for (int k = 0; k < 256; ++k) { const float2 wv = *reinterpret_cast<const float2*>(wp + (size_t)k * 6144);
#pragma unroll
                for (int r = 0; r < 9; ++r) { const float s = sp[r * 2048 + k]; a0[r] += s * wv.x; a1[r] += s * wv.y; } }
#pragma unroll
            for (int r = 0; r < 9; ++r) { red[(w * 9 + r) * 128 + lane * 2] = a0[r]; red[(w * 9 + r) * 128 + lane * 2 + 1] = a1[r]; }
            __syncthreads();
            for (int i = tid; i < 9 * 128; i += 512) { const int r = i >> 7, n = i & 127; float s = 0.f;
#pragma unroll
                for (int w2 = 0; w2 < 8; ++w2) s += red[(w2 * 9 + r) * 128 + n];
                p.mod[((size_t)l * 9 + r) * 6144 + n0 + n] = s + p.ada_b[l * 6144 + n0 + n]; }
            __syncthreads();
        }
    }
    {
        float* tile = (float*)lds;
        constexpr int T_IN = 4 * 32 * 256, T_BR = 12 * 16 * 32, T_OUT = 4 * 32 * 32;
        for (int t = wg; t < T_IN + T_BR + T_OUT; t += G) {
            const float* src; bf16_t* dst; int K, N, kt, nt;
            if (t < T_IN) { const int l = t / 8192, r = t - l * 8192; K = 2048; N = 16384; kt = r / 256; nt = r - kt * 256; src = p.w_in + (size_t)l * K * N; dst = p.WinT + (size_t)l * K * N; }
            else if (t < T_IN + T_BR) { const int t2 = t - T_IN, lx = t2 / 512, r = t2 - lx * 512, l = lx / 3, xb = lx - 3 * l; K = 1024; N = 2048; kt = r / 32; nt = r - kt * 32;
                src = (xb == 0 ? p.w_ba : (xb == 1 ? p.w_bb : p.w_bc)) + (size_t)l * K * N; dst = p.WbT + (size_t)lx * K * N; }
            else { const int t2 = t - T_IN - T_BR, l = t2 / 1024, r = t2 - l * 1024; K = 2048; N = 2048; kt = r / 32; nt = r - kt * 32; src = p.w_out + (size_t)l * K * N; dst = p.WoT + (size_t)l * K * N; }
            const int k0 = kt * 64, n0 = nt * 64;
            __syncthreads();
#pragma unroll
            for (int ps = 0; ps < 2; ++ps) { const int rr = (tid >> 4) + 32 * ps, c4 = (tid & 15) * 4;
                const float4 v = *reinterpret_cast<const float4*>(src + (size_t)(k0 + rr) * N + n0 + c4);
                tile[rr * 65 + c4] = v.x; tile[rr * 65 + c4 + 1] = v.y; tile[rr * 65 + c4 + 2] = v.z; tile[rr * 65 + c4 + 3] = v.w; }
            __syncthreads();
            { const int kg = tid & 7, n = tid >> 3; float v[8];
#pragma unroll
                for (int j = 0; j < 8; ++j) v[j] = tile[(kg * 8 + j) * 65 + n];
                const u32x4_ wv = {cvtpk2(v[0], v[1]), cvtpk2(v[2], v[3]), cvtpk2(v[4], v[5]), cvtpk2(v[6], v[7])};
                *reinterpret_cast<u32x4_*>(dst + (size_t)(n0 + n) * K + k0 + kg * 8) = wv; }
        }
        __syncthreads();
    }
    for (int i = wg * 512 + tid; i < SEQ * 64; i += G * 512) { const int pos = i >> 6, d = i & 63, fi = d & 31; const int base = d < 32 ? (pos >> 6) : (pos & 63);
        const float inv = powf(10000.f, -(float)fi / 32.f); const float ang = (float)base * inv; p.cos_t[i] = cosf(ang); p.sin_t[i] = sinf(ang); }
    for (int i = wg * 512 + tid; i < 2048; i += G * 512) { const float x0 = p.clb[i], x1 = p.clb[2048 + i], x2 = p.clb[4096 + i], x3 = p.clb[6144 + i];
        const float mx = fmaxf(fmaxf(x0, x1), fmaxf(x2, x3)); const float e0 = expf(x0 - mx), e1 = expf(x1 - mx), e2 = expf(x2 - mx), e3 = expf(x3 - mx); const float inv = 1.f / (e0 + e1 + e2 + e3);
        p.lbv[i] = 0.f; p.lbv[2048 + i] = e1 * inv; p.lbv[4096 + i] = (e1 + e2) * inv; p.lbv[6144 + i] = (e1 + e2 + e3) * inv; }
}

__device__ __forceinline__ void ph_norm(const Params& p, int l) {
    const int tid = tidx(), w = tid >> 6, lane = tid & 63;
    const float* g = p.norm_g + l * DM;
    for (int row = blockIdx.x * 8 + w; row < TT; row += gridDim.x * 8) {
        const int b = row / TPB, pp = row - b * TPB;
        const float* src = l == 0 ? (pp < CTXL ? p.ctx + ((size_t)b * CTXL + pp) * DM : p.x + ((size_t)b * SEQ + pp - CTXL) * DM) : p.resid + (size_t)row * DM;
        const float* md = p.mod + ((size_t)l * 9 + (pp < CTXL ? 8 : b)) * 6144;
        float4 v[8]; float ss = 0.f;
#pragma unroll
        for (int i = 0; i < 8; ++i) { v[i] = *reinterpret_cast<const float4*>(src + i * 256 + lane * 4); ss += v[i].x * v[i].x + v[i].y * v[i].y + v[i].z * v[i].z + v[i].w * v[i].w; }
        ss = wave_sum(ss);
        const float rstd = rsqrtf(ss * (1.f / DM) + 1e-6f);
#pragma unroll
        for (int i = 0; i < 8; ++i) { const int col = i * 256 + lane * 4;
            const float4 gv = *reinterpret_cast<const float4*>(g + col), sh = *reinterpret_cast<const float4*>(md + col), sc = *reinterpret_cast<const float4*>(md + 2048 + col);
            const float y0 = v[i].x * rstd * gv.x * (1.f + sc.x) + sh.x, y1 = v[i].y * rstd * gv.y * (1.f + sc.y) + sh.y;
            const float y2 = v[i].z * rstd * gv.z * (1.f + sc.z) + sh.z, y3 = v[i].w * rstd * gv.w * (1.f + sc.w) + sh.w;
            uint2 o; o.x = cvtpk2(y0, y1); o.y = cvtpk2(y2, y3);
            *reinterpret_cast<uint2*>(p.hbuf + (size_t)row * DM + col) = o; }
    }
}

__device__ __forceinline__ void ph_kfix(const Params& p, int l) {
    const int tid = tidx(), w = tid >> 6, lane = tid & 63;
    for (int task = blockIdx.x * 8 + w; task < TT * 4; task += gridDim.x * 8) {
        const int row = task >> 2, hh = task & 3; const int b = row / TPB, pp = row - b * TPB; const bool lat = pp >= CTXL;
        if (hh < 2 && !lat) continue;
        bf16_t* kp = p.proj + (size_t)row * NP + (hh < 2 ? COL_AK + hh * 128 : COL_BK + (hh - 2) * 128);
        float x1 = bf2f(kp[lane]), x2 = bf2f(kp[64 + lane]);
        if (hh >= 2) { const float ss = wave_sum(x1 * x1 + x2 * x2); const float rstd = rsqrtf(ss * (1.f / 128.f) + 1e-6f);
            x1 *= rstd * p.b_kn[l * 128 + lane]; x2 *= rstd * p.b_kn[l * 128 + 64 + lane]; }
        if (lat) { const int pos = pp - CTXL; const float cs = p.cos_t[pos * 64 + lane], sn = p.sin_t[pos * 64 + lane]; const float y1 = x1 * cs - x2 * sn, y2 = x2 * cs + x1 * sn; x1 = y1; x2 = y2; }
        kp[lane] = f2bf(x1); kp[64 + lane] = f2bf(x2);
    }
}

__device__ __forceinline__ void ph_ccomb(const Params& p, int l) {
    const int tid = tidx(), w = tid >> 6, lane = tid & 63;
    for (int task = blockIdx.x * 8 + w; task < TT * 8; task += gridDim.x * 8) {
        const int row = task >> 3, h = task & 7;
        const size_t off = (size_t)row * 1024 + h * 128 + lane * 2;
        const float2 a = *reinterpret_cast<const float2*>(p.pbuf + off), bb = *reinterpret_cast<const float2*>(p.pbuf + (size_t)TT * 1024 + off);
        const float s0 = a.x + bb.x, s1 = a.y + bb.y;
        const float ss = wave_sum(s0 * s0 + s1 * s1); const float rstd = rsqrtf(ss * (1.f / 128.f) + 1e-6f);
        const float2 gn = *reinterpret_cast<const float2*>(p.c_gn + l * 128 + lane * 2);
        const unsigned zz = *reinterpret_cast<const unsigned*>(p.proj + (size_t)row * NP + COL_CZ + h * 128 + lane * 2);
        const float z0 = __uint_as_float(zz << 16), z1 = __uint_as_float(zz & 0xffff0000u);
        *reinterpret_cast<unsigned*>(p.gin + (size_t)2 * TT * 1024 + off) = cvtpk2(s0 * rstd * gn.x * siluf_(z0), s1 * rstd * gn.y * siluf_(z1));
    }
}

__device__ __forceinline__ void ph_final(const Params& p) {
    const int tid = tidx(), w = tid >> 6, lane = tid & 63;
    for (int r = blockIdx.x * 8 + w; r < NB * SEQ; r += gridDim.x * 8) {
        const int b = r / SEQ, t = r - b * SEQ;
        const float* src = p.resid + ((size_t)b * TPB + CTXL + t) * DM;
        float4 v[8]; float ss = 0.f;
#pragma unroll
        for (int i = 0; i < 8; ++i) { v[i] = *reinterpret_cast<const float4*>(src + i * 256 + lane * 4); ss += v[i].x * v[i].x + v[i].y * v[i].y + v[i].z * v[i].z + v[i].w * v[i].w; }
        ss = wave_sum(ss);
        const float rstd = rsqrtf(ss * (1.f / DM) + 1e-6f);
#pragma unroll
        for (int i = 0; i < 8; ++i) { const int col = i * 256 + lane * 4; const float4 gv = *reinterpret_cast<const float4*>(p.final_g + col);
            float4 o; o.x = v[i].x * rstd * gv.x; o.y = v[i].y * rstd * gv.y; o.z = v[i].z * rstd * gv.z; o.w = v[i].w * rstd * gv.w;
            *reinterpret_cast<float4*>(p.out + (size_t)r * DM + col) = o; }
    }
}

__device__ __forceinline__ void ph_attn(const Params& p, int l, unsigned char* lds) {
    const int G = gridDim.x; const bool with_ctx = l < DEPTH - 1;
    for (int pass = 0; pass < 2; ++pass)
        for (int i = blockIdx.x; i < 512; i += G) {
            const int c = i & 255, rnd = i >> 8, xcd = c & 7, j = c >> 3, gi = xcd + 8 * rnd, b = gi >> 1, kvh = gi & 1, h = kvh * 4 + (j >> 3), qt = j & 7;
            if (pass == 0) att::attn_item<1>(p, l, b, h, qt, (char*)lds); else att::attn_item<0>(p, l, b, h, qt, (char*)lds);
        }
    if (with_ctx)
        for (int i = blockIdx.x; i < 128; i += G) { const int md = i & 1, bh = i >> 1, b = bh >> 3, h = bh & 7;
            if (md) att::attn_item<1>(p, l, b, h, 8, (char*)lds); else att::attn_item<0>(p, l, b, h, 8, (char*)lds); }
}

__global__ void __launch_bounds__(512, 2) mega_fwd(Params p) {
    extern __shared__ __attribute__((aligned(16))) unsigned char lds[];
    cg::grid_group grid_ = cg::this_grid();
#define GSYNC() do { __builtin_amdgcn_fence(__ATOMIC_RELEASE, "agent"); grid_.sync(); __builtin_amdgcn_fence(__ATOMIC_ACQUIRE, "agent"); } while (0)
    const int G = gridDim.x, c = blockIdx.x;
    ph_prologue(p, lds);
    GSYNC();
    for (int l = 0; l < DEPTH; ++l) {
        const bool last = l == DEPTH - 1;
        ph_norm(p, l);
        GSYNC();
        { pg8::Gemm g; g.A = p.hbuf; g.Bt = p.WinT + (size_t)l * NP * DM; g.M = TT; g.N = NP; g.K = DM;
          Order S; S.init(72, 64, 1, 0, G, c); EpiProj E; E.O = p.proj;
          pg8::gemm_phase<EpiProj, Order, false>((PG8_LAS unsigned char*)lds, g, S, E, nullptr); }
        GSYNC();
        ph_kfix(p, l);
        for (int i = c; i < 256; i += G) hg::hgrn_item(p, l, i, lds);
        GSYNC();
        ph_attn(p, l, lds);
        ph_ccomb(p, l);
        GSYNC();
        { pg8::Gemm g; g.A = p.gin; g.Bt = p.WbT + (size_t)l * 3 * DM * 1024; g.M = TT; g.N = DM; g.K = 1024;
          Order S; S.init(last ? 64 : 72, 8, 3, last ? 1 : 0, G, c); EpiBranch E; E.proj = p.proj; E.pbuf = p.pbuf; E.merged = p.hbuf;
          pg8::gemm_phase<EpiBranch, Order, false>((PG8_LAS unsigned char*)lds, g, S, E, nullptr); }
        GSYNC();
        { pg8::Gemm g; g.A = p.hbuf; g.Bt = p.WoT + (size_t)l * DM * DM; g.M = TT; g.N = DM; g.K = DM;
          Order S; S.init(last ? 64 : 72, 8, 1, last ? 1 : 0, G, c); EpiOut E; E.x = p.x; E.ctx = p.ctx; E.resid = p.resid; E.modl = p.mod + (size_t)l * 9 * 6144; E.layer0 = l == 0;
          pg8::gemm_phase<EpiOut, Order, false>((PG8_LAS unsigned char*)lds, g, S, E, nullptr); }
        GSYNC();
    }
    ph_final(p);
}

extern "C" void kernel_launch(void* const* d_in, const int* in_sizes, int n_in, void* d_out, int out_size, void* d_ws, size_t ws_size, hipStream_t stream) {
    constexpr size_t SZ_WIN = (size_t)DEPTH * NP * DM * 2, SZ_WB = (size_t)DEPTH * 3 * DM * 1024 * 2, SZ_WO = (size_t)DEPTH * DM * DM * 2, SZ_RES = (size_t)TT * DM * 4, SZ_H = (size_t)TT * DM * 2,
                     SZ_PROJ = (size_t)TT * NP * 2, SZ_GIN = (size_t)3 * TT * 1024 * 2, SZ_PB = (size_t)TT * DM * 4, SZ_MOD = (size_t)DEPTH * 9 * 6144 * 4, SZ_LB = 8192 * 4, SZ_ROPE = (size_t)SEQ * 64 * 4;
    constexpr size_t O_WIN = 0, O_WB = O_WIN + SZ_WIN, O_WO = O_WB + SZ_WB, O_RES = O_WO + SZ_WO, O_H = O_RES + SZ_RES, O_PROJ = O_H + SZ_H, O_GIN = O_PROJ + SZ_PROJ, O_PB = O_GIN + SZ_GIN,
                     O_MOD = O_PB + SZ_PB, O_LB = O_MOD + ((SZ_MOD + 255) / 256) * 256, O_COS = O_LB + SZ_LB, O_SIN = O_COS + SZ_ROPE, O_END = O_SIN + SZ_ROPE;
    static int grid_blocks = 0;
    if (grid_blocks == 0) {
        if (n_in != 18 || out_size != NB * SEQ * DM || ws_size < O_END) { fprintf(stderr, "kernel_launch: unexpected shapes (n_in %d out %d ws %zu need %zu)\n", n_in, out_size, ws_size, (size_t)O_END); grid_blocks = -1; return; }
        int dev = 0, cus = 0, per_cu = 0;
        hipGetDevice(&dev);
        hipDeviceGetAttribute(&cus, hipDeviceAttributeMultiprocessorCount, dev);
        if (hipFuncSetAttribute((const void*)mega_fwd, hipFuncAttributeMaxDynamicSharedMemorySize, LDS_BYTES) != hipSuccess) { fprintf(stderr, "kernel_launch: hipFuncSetAttribute failed\n"); grid_blocks = -1; return; }
        if (hipOccupancyMaxActiveBlocksPerMultiprocessor(&per_cu, (const void*)mega_fwd, 512, LDS_BYTES) != hipSuccess || per_cu < 1) { fprintf(stderr, "kernel_launch: occupancy query failed (%d)\n", per_cu); (void)hipGetLastError(); per_cu = 1; }
        grid_blocks = cus * per_cu;
    }
    if (grid_blocks < 0) return;
    Params p{};
    p.x = (const float*)d_in[0]; p.c = (const float*)d_in[1]; p.ctx = (const float*)d_in[2]; p.c_ctx = (const float*)d_in[3]; p.ada_w = (const float*)d_in[4]; p.ada_b = (const float*)d_in[5];
    p.norm_g = (const float*)d_in[6]; p.w_in = (const float*)d_in[7]; p.a_sink = (const float*)d_in[8]; p.b_qn = (const float*)d_in[9]; p.b_kn = (const float*)d_in[10]; p.clb = (const float*)d_in[11];
    p.c_gn = (const float*)d_in[12]; p.w_ba = (const float*)d_in[13]; p.w_bb = (const float*)d_in[14]; p.w_bc = (const float*)d_in[15]; p.w_out = (const float*)d_in[16]; p.final_g = (const float*)d_in[17];
    p.out = (float*)d_out;
    char* ws = (char*)d_ws;
    p.WinT = (bf16_t*)(ws + O_WIN); p.WbT = (bf16_t*)(ws + O_WB); p.WoT = (bf16_t*)(ws + O_WO); p.resid = (float*)(ws + O_RES); p.hbuf = (bf16_t*)(ws + O_H); p.proj = (bf16_t*)(ws + O_PROJ);
    p.gin = (bf16_t*)(ws + O_GIN); p.pbuf = (float*)(ws + O_PB); p.mod = (float*)(ws + O_MOD); p.lbv = (float*)(ws + O_LB); p.cos_t = (float*)(ws + O_COS); p.sin_t = (float*)(ws + O_SIN);
    void* args[] = {&p};
    const hipError_t e = hipLaunchCooperativeKernel((const void*)mega_fwd, dim3(grid_blocks), dim3(512), args, LDS_BYTES, stream);
    if (e != hipSuccess) fprintf(stderr, "kernel_launch: cooperative launch failed: %s (grid %d)\n", hipGetErrorString(e), grid_blocks);
}
```

```cpp
#include <hip/hip_runtime.h>
#include <hip/hip_bf16.h>
#include <hip/hip_cooperative_groups.h>
#include <cstdio>
#include <cstdint>
namespace cg = cooperative_groups;

constexpr int NB = 8, SEQ = 2048, CTXL = 256, TPB = SEQ + CTXL, TT = NB * TPB, DM = 2048, NP = 16384, DEPTH = 4;
constexpr int COL_AQ = 0, COL_AK = 1024, COL_AV = 1280, COL_AZ = 1536, COL_BQ = 2560, COL_BK = 3584, COL_BV = 3840, COL_BZ = 4096;
constexpr int COL_CQ = 5120, COL_CZF = 6144, COL_CZB = 7168, COL_CI = 8192, COL_CZ = 9216, COL_GATE = 10240;
constexpr int LDS_BYTES = 131072 + 64;
typedef unsigned short bf16_t;

struct Params {
    const float* x; const float* c; const float* ctx; const float* c_ctx; const float* ada_w; const float* ada_b; const float* norm_g; const float* w_in;
    const float* a_sink; const float* b_qn; const float* b_kn; const float* clb; const float* c_gn; const float* w_ba; const float* w_bb; const float* w_bc;
    const float* w_out; const float* final_g;
    float* out;
    bf16_t* WinT; bf16_t* WbT; bf16_t* WoT; float* resid; bf16_t* hbuf; bf16_t* proj; bf16_t* gin; float* pbuf; float* mod; float* lbv; float* cos_t; float* sin_t; unsigned* bar;
};

__device__ __forceinline__ size_t pidx(int row, int col) { return ((size_t)(col >> 7) * TT + row) * 128 + (col & 127); }
__device__ __forceinline__ float bf2f(bf16_t u) { return __uint_as_float(((unsigned)u) << 16); }
typedef __bf16 bf16x2_ __attribute__((ext_vector_type(2)));
__device__ __forceinline__ unsigned cvtpk2(float lo, float hi) { bf16x2_ v; v[0] = (__bf16)lo; v[1] = (__bf16)hi; return __builtin_bit_cast(unsigned, v); }
__device__ __forceinline__ bf16_t f2bf(float f) { return (bf16_t)(cvtpk2(f, f) & 0xffffu); }
__device__ __forceinline__ float sigmoidf_(float z) { return 1.f / (1.f + __expf(-z)); }
__device__ __forceinline__ float siluf_(float z) { return z / (1.f + __expf(-z)); }
__device__ __forceinline__ float sigmoid_fast(float z) { return __builtin_amdgcn_rcpf(1.f + __expf(-z)); }
__device__ __forceinline__ float silu_fast(float z) { return z * __builtin_amdgcn_rcpf(1.f + __expf(-z)); }
__device__ __forceinline__ float wave_sum(float v) {
#pragma unroll
    for (int o = 32; o >= 1; o >>= 1) v += __shfl_xor(v, o);
    return v;
}

__device__ __forceinline__ int tidx() { int t = threadIdx.x; asm volatile("" : "+v"(t)); return t; }
namespace pg8 {
#define PG8_LAS __attribute__((address_space(3)))
typedef unsigned short bf16_t;
typedef short bf16x8 __attribute__((ext_vector_type(8)));
typedef float f32x4 __attribute__((ext_vector_type(4)));
typedef unsigned u32x4 __attribute__((ext_vector_type(4)));
constexpr int BM = 256, BK = 64, HALF = 128, HTB = HALF * BK * 2  , STAGE_BYTES = 8 * HTB, NXCD = 8, WGM = 8;

__host__ __device__ __forceinline__ int lds_byte(int r, int c) { const int st = (r >> 4) * 2 + (c >> 5), rr = r & 15, cc = c & 31, ob = rr * 64 + cc * 2; return st * 1024 + (ob ^ (((ob >> 9) & 1) << 5)); }
__host__ __device__ __forceinline__ void stage_rc(int b, int& R, int& C) { const int st = b / 1024, sb = b % 1024, swz = sb ^ (((sb >> 9) & 1) << 5); R = (st >> 1) * 16 + swz / 64; C = (st & 1) * 32 + (swz % 64) / 2; }
__host__ __device__ __forceinline__ int perm32(int rho) { const int n = rho >> 4, i = rho & 15; return 8 * (i >> 2) + 4 * n + (i & 3); }

struct Unit { int pm, pn; };
struct Gemm { const bf16_t* A; const bf16_t* Bt; int M, N, K; };

struct StaticOrder {
    int nM, nN, nwg, G, c;
    __host__ __device__ void init(int M, int N, int G_, int c_) { nM = M / BM; nN = N / BM; nwg = nM * nN; G = G_; c = c_; }
    __host__ __device__ bool next(int i, Unit& u) const {
        const long L = (long)i * G + c; if (L >= nwg) return false;
        int wgid = (int)L; { const int q = nwg / NXCD, r = nwg % NXCD, xcd = wgid % NXCD, off = wgid / NXCD; wgid = (xcd < r ? xcd * (q + 1) : r * (q + 1) + (xcd - r) * q) + off; }
        const int nig = WGM * nN, gid = wgid / nig, fm = gid * WGM, gsz = (nM - fm) < WGM ? (nM - fm) : WGM;
        u.pm = fm + ((wgid % nig) % gsz); u.pn = (wgid % nig) / gsz; return true;
    }
    __device__ __forceinline__ void a_ready(const Unit&) const {}
    __device__ __forceinline__ void done(const Unit&) const {}
};

template <class Epi, class Sched, bool STAMP = false>
__device__ __forceinline__ void gemm_phase(PG8_LAS unsigned char* lds, const Gemm g, const Sched& S, const Epi& E, unsigned long long* stamps) {
    const int tid = tidx(), wid = __builtin_amdgcn_readfirstlane(tid >> 6), lane = tid & 63, wr = wid >> 2, wc = wid & 3, fr = lane & 15, fq = lane >> 4;
    const int K = g.K, nt = K / BK;
    int ts_lo = 0, ts_hi = 0, nts = 0; const unsigned long long rt_entry = STAMP ? (unsigned long long)wall_clock64() : 0ull;
#define PG8_STAMP() do { if (STAMP && wid == 0 && nts < 64) { const unsigned long long _c = (unsigned long long)clock64(); \
        ts_lo = (lane == nts) ? (int)(unsigned)_c : ts_lo; ts_hi = (lane == nts) ? (int)(unsigned)(_c >> 32) : ts_hi; ++nts; } } while (0)
    PG8_STAMP();
    unsigned voffA[2], voffB[2];
#pragma unroll
    for (int i = 0; i < 2; ++i) { int R, C; stage_rc(tid * 16 + i * 8192, R, C); const int Rb = Epi::PERM ? ((R & ~31) + perm32(R & 31)) : R;
        voffA[i] = (unsigned)(R * K + C) * 2u; voffB[i] = (unsigned)(Rb * K + C) * 2u; }
    const size_t kstep = (size_t)(BK * 2);
    const size_t hstep = (size_t)HALF * K * 2;
    const size_t tstep = 2 * hstep;
    const unsigned ldsw = (unsigned)wid * 1024u;
    const int aoff = lds_byte(wr * 64 + fr, fq * 8), boff = lds_byte(wc * 32 + fr, fq * 8);
#define PG8_SA(b, h) (((b) * 2 + (h)) * HTB)
#define PG8_SB(b, h) ((4 + (b) * 2 + (h)) * HTB)
#define PG8_STAGE(bufoff, gbase, voff) do { _Pragma("unroll") for (int _i = 0; _i < 2; ++_i) \
        __builtin_amdgcn_global_load_lds((const unsigned*)((const char*)(gbase) + (voff)[_i]), (PG8_LAS unsigned*)(lds + (bufoff) + ldsw + _i * 8192), 16, 0, 0); } while (0)
#define PG8_LDA(dst, b, h) do { _Pragma("unroll") for (int m = 0; m < 4; ++m) _Pragma("unroll") for (int k = 0; k < 2; ++k) dst[m][k] = *(const PG8_LAS bf16x8*)(lds + PG8_SA(b, h) + aoff + m * 2048 + k * 1024); } while (0)
#define PG8_LDB(dst, b, h) do { _Pragma("unroll") for (int n = 0; n < 2; ++n) _Pragma("unroll") for (int k = 0; k < 2; ++k) dst[n][k] = *(const PG8_LAS bf16x8*)(lds + PG8_SB(b, h) + boff + n * 2048 + k * 1024); } while (0)
#define PG8_MMA(ai, bj, At, Bt) do { __builtin_amdgcn_s_setprio(1); _Pragma("unroll") for (int m = 0; m < 4; ++m) _Pragma("unroll") for (int n = 0; n < 2; ++n) _Pragma("unroll") for (int k = 0; k < 2; ++k) \
        acc[ai][bj][m][n] = __builtin_amdgcn_mfma_f32_16x16x32_bf16(Bt[n][k], At[m][k], acc[ai][bj][m][n], 0, 0, 0); __builtin_amdgcn_s_setprio(0); } while (0)
#define PG8_WAIT_V(n) asm volatile("s_waitcnt vmcnt(" #n ")" ::: "memory")
#define PG8_WAIT_L(n) asm volatile("s_waitcnt lgkmcnt(" #n ")" ::: "memory")
#define PG8_BAR __builtin_amdgcn_s_barrier()
#define PG8_SCHED __builtin_amdgcn_sched_barrier(0)
    Unit cur, nxt; int ui = 0;
    if (!S.next(0, cur)) return;
    f32x4 acc[2][2][4][2];
#pragma unroll
    for (int a = 0; a < 2; ++a)
#pragma unroll
        for (int b = 0; b < 2; ++b)
#pragma unroll
            for (int m = 0; m < 4; ++m)
#pragma unroll
                for (int n = 0; n < 2; ++n) acc[a][b][m][n] = (f32x4){0.f, 0.f, 0.f, 0.f};
    bf16x8 At[4][2], B0[2][2], B1[2][2];
    const char* cA = (const char*)g.A + (size_t)cur.pm * tstep; const char* cB = (const char*)g.Bt + (size_t)cur.pn * tstep;
    S.a_ready(cur);
    PG8_STAGE(PG8_SB(0, 0), cB, voffB); PG8_STAGE(PG8_SA(0, 0), cA, voffA); PG8_STAGE(PG8_SB(0, 1), cB + hstep, voffB); PG8_STAGE(PG8_SA(0, 1), cA + hstep, voffA);
    if (wr == 1) PG8_BAR;
    PG8_WAIT_V(4); PG8_BAR;
    PG8_STAGE(PG8_SB(1, 0), cB + kstep, voffB); PG8_STAGE(PG8_SA(1, 0), cA + kstep, voffA); PG8_STAGE(PG8_SB(1, 1), cB + hstep + kstep, voffB);
    PG8_WAIT_V(6); PG8_BAR;
    PG8_STAMP();
    for (;;) {
        const bool has_next = S.next(ui + 1, nxt);
        const char* nA = has_next ? (const char*)g.A + (size_t)nxt.pm * tstep : cA; const char* nB = has_next ? (const char*)g.Bt + (size_t)nxt.pn * tstep : cB;
        for (int t = 0; t < nt; t += 2) {
            const bool last = (t == nt - 2);
            const char* a1 = cA + (size_t)(t + 1) * kstep;
            const char* a2 = last ? nA : cA + (size_t)(t + 2) * kstep; const char* b2 = last ? nB : cB + (size_t)(t + 2) * kstep;
            const char* a3 = a2 + kstep; const char* b3 = b2 + kstep;
            if (last && has_next) S.a_ready(nxt);
            if constexpr (Epi::HAS_MID) { if (t == 16 || t == 32) E.mid(acc, cur, t, wr, wc, fr, fq); }
            PG8_LDB(B0, 0, 0); PG8_SCHED; PG8_LDA(At, 0, 0); PG8_STAGE(PG8_SA(1, 1), a1 + hstep, voffA);
            PG8_WAIT_L(8); PG8_BAR; PG8_WAIT_L(0); PG8_MMA(0, 0, At, B0); PG8_BAR; PG8_SCHED;
            PG8_LDB(B1, 0, 1); PG8_STAGE(PG8_SB(0, 0), b2, voffB);
            PG8_BAR; PG8_WAIT_L(0); PG8_MMA(0, 1, At, B1); PG8_BAR;
            PG8_LDA(At, 0, 1); PG8_STAGE(PG8_SA(0, 0), a2, voffA);
            PG8_BAR; PG8_WAIT_L(0); PG8_MMA(1, 0, At, B0); PG8_BAR; PG8_SCHED;
            PG8_STAGE(PG8_SB(0, 1), b2 + hstep, voffB);
            PG8_WAIT_V(6); PG8_BAR; PG8_MMA(1, 1, At, B1); PG8_BAR;
            PG8_LDB(B0, 1, 0); PG8_SCHED; PG8_LDA(At, 1, 0); PG8_STAGE(PG8_SA(0, 1), a2 + hstep, voffA);
            PG8_WAIT_L(8); PG8_BAR; PG8_WAIT_L(0); PG8_MMA(0, 0, At, B0); PG8_BAR; PG8_SCHED;
            PG8_LDB(B1, 1, 1); PG8_STAGE(PG8_SB(1, 0), b3, voffB);
            PG8_BAR; PG8_WAIT_L(0); PG8_MMA(0, 1, At, B1); PG8_BAR;
            PG8_LDA(At, 1, 1); PG8_STAGE(PG8_SA(1, 0), a3, voffA);
            PG8_BAR; PG8_WAIT_L(0); PG8_MMA(1, 0, At, B0); PG8_BAR; PG8_SCHED;
            PG8_STAGE(PG8_SB(1, 1), b3 + hstep, voffB);
            PG8_WAIT_V(6); PG8_BAR; PG8_MMA(1, 1, At, B1); PG8_BAR;
        }
        PG8_STAMP();
        if constexpr (!Epi::AFTER_DRAIN) { E(acc, cur, wr, wc, fr, fq); S.done(cur); }
        PG8_STAMP();
        if (!has_next) break;
#pragma unroll
        for (int a = 0; a < 2; ++a)
#pragma unroll
            for (int b = 0; b < 2; ++b)
#pragma unroll
                for (int m = 0; m < 4; ++m)
#pragma unroll
                    for (int n = 0; n < 2; ++n) acc[a][b][m][n] = (f32x4){0.f, 0.f, 0.f, 0.f};
        cur = nxt; cA = nA; cB = nB; ++ui;
    }
    PG8_WAIT_V(0);
    if (wr == 0) PG8_BAR;
    PG8_BAR;
    if constexpr (Epi::AFTER_DRAIN) { E.fused(acc, cur, wr, wc, fr, fq, lds, wid, lane); S.done(cur); }
    PG8_STAMP();
    if (STAMP && wid == 0) { stamps[lane] = lane < nts ? (((unsigned long long)(unsigned)ts_hi << 32) | (unsigned)ts_lo) : 0ull;
        if (lane == 62) stamps[62] = rt_entry; if (lane == 63) stamps[63] = (unsigned long long)wall_clock64(); }
#undef PG8_STAMP
#undef PG8_SA
#undef PG8_SB
#undef PG8_STAGE
#undef PG8_LDA
#undef PG8_LDB
#undef PG8_MMA
#undef PG8_WAIT_V
#undef PG8_WAIT_L
#undef PG8_BAR
#undef PG8_SCHED
}
}

namespace att {
using bf16 = __hip_bfloat16;
constexpr int D = 128, NW = 8, QBLK = 32, KVBLK = 64;
constexpr float SCALE = 0.088388347648318440f;
constexpr float THR = 8.f;
constexpr size_t SHM_V = KVBLK * D * 2, SHM_K = KVBLK * D * 2;
constexpr int LDK = 128;
using bf16x8 = __attribute__((ext_vector_type(8))) short;
using s16x4  = __attribute__((ext_vector_type(4))) short;
using f32x16 = __attribute__((ext_vector_type(16))) float;
using f32x8  = __attribute__((ext_vector_type(8))) float;
using u32x4  = __attribute__((ext_vector_type(4))) unsigned;
#define KSWZ(row, colB) ((row) * 256 + ((colB) ^ (((row) & 7) << 4)))
#define SBAR() __builtin_amdgcn_sched_barrier(0)
__device__ __forceinline__ int crow(int r, int hi) { return (r & 3) + 8 * (r >> 2) + 4 * hi; }
__device__ __forceinline__ unsigned cvtpk(float lo, float hi) {
  unsigned r; asm volatile("v_cvt_pk_bf16_f32 %0, %1, %2" : "=v"(r) : "v"(lo), "v"(hi)); return r;
}
template <typename TIn> struct Stage;
template <> struct Stage<bf16>  { using T = bf16x8;
  __device__ static __forceinline__ T ld8(const bf16* p) { return *reinterpret_cast<const bf16x8*>(p); }
  __device__ static __forceinline__ bf16x8 tobf(T x) { return x; } };
template <> struct Stage<float> { using T = f32x8;
  __device__ static __forceinline__ T ld8(const float* p) { return *reinterpret_cast<const f32x8*>(p); }
  __device__ static __forceinline__ bf16x8 tobf(T x) {
    u32x4 w = {cvtpk(x[0], x[1]), cvtpk(x[2], x[3]), cvtpk(x[4], x[5]), cvtpk(x[6], x[7])}; return *reinterpret_cast<bf16x8*>(&w); } };

__device__ __forceinline__ void partialSM(f32x16& p0, f32x16& p1, float& m_reg, float& mn, float& alpha) {
  constexpr float C = SCALE * 1.4426950408889634f;
  float pmax = p0[0]; for (int r = 1; r < 16; ++r) pmax = fmaxf(pmax, p0[r]); for (int r = 0; r < 16; ++r) pmax = fmaxf(pmax, p1[r]);
  { auto rr = __builtin_amdgcn_permlane32_swap(__float_as_uint(pmax), __float_as_uint(pmax), false, false);
    pmax = fmaxf(__uint_as_float(rr[0]), __uint_as_float(rr[1])); }
  if (__builtin_expect(__all(pmax - m_reg <= THR / SCALE), 1)) { mn = m_reg; alpha = 1.f; }
  else { mn = fmaxf(m_reg, pmax); alpha = __builtin_amdgcn_exp2f((m_reg - mn) * C); m_reg = mn; }
  float mnC = -mn * C;
  for (int r = 0; r < 16; ++r) p0[r] = fmaf(p0[r], C, mnC); for (int r = 0; r < 16; ++r) p1[r] = fmaf(p1[r], C, mnC);
  for (int r = 0; r < 16; ++r) p0[r] = __builtin_amdgcn_exp2f(p0[r]);
}
__device__ __forceinline__ void finishSM(f32x16& p0, f32x16& p1, float alpha, float& l_reg, bf16x8& pa0, bf16x8& pa1, bf16x8& pa2, bf16x8& pa3) {
  for (int r = 0; r < 16; ++r) p1[r] = __builtin_amdgcn_exp2f(p1[r]);
  float ps = 0; for (int r = 0; r < 16; ++r) ps += p0[r]; for (int r = 0; r < 16; ++r) ps += p1[r];
  { auto rr = __builtin_amdgcn_permlane32_swap(__float_as_uint(ps), __float_as_uint(ps), false, false);
    ps = __uint_as_float(rr[0]) + __uint_as_float(rr[1]); }
  l_reg = l_reg * alpha + ps;
#define PK4(P, BASE, OUT) do { unsigned a0 = cvtpk(P[BASE + 0], P[BASE + 1]), a1 = cvtpk(P[BASE + 2], P[BASE + 3]);   \
    unsigned b0 = cvtpk(P[BASE + 4], P[BASE + 5]), b1 = cvtpk(P[BASE + 6], P[BASE + 7]);                              \
    auto r0 = __builtin_amdgcn_permlane32_swap(a0, b0, false, false); auto r1 = __builtin_amdgcn_permlane32_swap(a1, b1, false, false); \
    u32x4 w = {r0[0], r1[0], r0[1], r1[1]}; OUT = *reinterpret_cast<bf16x8*>(&w); } while (0)
  PK4(p0, 0, pa0); PK4(p0, 8, pa1); PK4(p1, 0, pa2); PK4(p1, 8, pa3);
#undef PK4
}
__device__ __forceinline__ void qkt(f32x16& p0, f32x16& p1, const bf16* Ks, const bf16x8* qr, int r32, int hi) {
  p0 = f32x16{}; p1 = f32x16{};
  for (int d0 = 0; d0 < 8; ++d0) { int cb = (d0 * 16 + hi * 8) * 2;
    bf16x8 b0 = *reinterpret_cast<const bf16x8*>((const char*)Ks + KSWZ(r32, cb));
    bf16x8 b1 = *reinterpret_cast<const bf16x8*>((const char*)Ks + KSWZ(32 + r32, cb));
    p0 = __builtin_amdgcn_mfma_f32_32x32x16_bf16(b0, qr[d0], p0, 0, 0, 0);
    p1 = __builtin_amdgcn_mfma_f32_32x32x16_bf16(b1, qr[d0], p1, 0, 0, 0); }
}
__device__ __forceinline__ int v_st(int k, int c) { const int kk = (k & ~0xC) | ((k & 4) << 1) | ((k & 8) >> 1); return ((kk >> 3) * 4 + (c >> 5)) * 512 + ((kk & 7) * 32 + (c & 31)) * 2; }
__device__ __forceinline__ int v_rd_base(int lane) { return ((lane & 3) << 3) | (((lane >> 2) & 3) << 6) | (((lane >> 4) & 1) << 5) | (((lane >> 5) & 1) << 8); }
constexpr int v_rd_off(int d0, int ks, int half) { return d0 * 512 + ks * 4096 + half * 2048; }
template <int OFF> __device__ __forceinline__ s16x4 tr_read(int vb) {
  s16x4 r; asm volatile("ds_read_b64_tr_b16 %0, %1 offset:%2" : "=&v"(r) : "v"(vb), "i"(OFF) : "memory"); return r;
}
template <int D0> __device__ __forceinline__ void pv_one(f32x16& od, int vb, bf16x8 pa0, bf16x8 pa1, bf16x8 pa2, bf16x8 pa3) {
  const s16x4 l0 = tr_read<v_rd_off(D0, 0, 0)>(vb), h0 = tr_read<v_rd_off(D0, 0, 1)>(vb), l1 = tr_read<v_rd_off(D0, 1, 0)>(vb), h1 = tr_read<v_rd_off(D0, 1, 1)>(vb);
  const s16x4 l2 = tr_read<v_rd_off(D0, 2, 0)>(vb), h2 = tr_read<v_rd_off(D0, 2, 1)>(vb), l3 = tr_read<v_rd_off(D0, 3, 0)>(vb), h3 = tr_read<v_rd_off(D0, 3, 1)>(vb);
  asm volatile("s_waitcnt lgkmcnt(0)" ::: "memory"); SBAR();
#define PK(L, H) (bf16x8){L[0], L[1], L[2], L[3], H[0], H[1], H[2], H[3]}
  od = __builtin_amdgcn_mfma_f32_32x32x16_bf16(pa0, PK(l0, h0), od, 0, 0, 0);
  od = __builtin_amdgcn_mfma_f32_32x32x16_bf16(pa1, PK(l1, h1), od, 0, 0, 0);
  od = __builtin_amdgcn_mfma_f32_32x32x16_bf16(pa2, PK(l2, h2), od, 0, 0, 0);
  od = __builtin_amdgcn_mfma_f32_32x32x16_bf16(pa3, PK(l3, h3), od, 0, 0, 0);
#undef PK
}
__device__ __forceinline__ void pv_d0(f32x16* o, int vb, bf16x8 pa0, bf16x8 pa1, bf16x8 pa2, bf16x8 pa3) {
  pv_one<0>(o[0], vb, pa0, pa1, pa2, pa3); pv_one<1>(o[1], vb, pa0, pa1, pa2, pa3); pv_one<2>(o[2], vb, pa0, pa1, pa2, pa3); pv_one<3>(o[3], vb, pa0, pa1, pa2, pa3);
}

template <int MODE>
__device__ __forceinline__ void attn_item(const Params& p, int l, int b, int h, int qt, char* lds) {
  using St = Stage<bf16>;
  const int tid = tidx(), wid = __builtin_amdgcn_readfirstlane(tid >> 6), lane = tid & 63, r32 = lane & 31, hi = lane >> 5;
  const bool isLat = qt < 8;
  const int q0 = isLat ? qt * 256 : 0;
  const int qrow0 = b * TPB + (isLat ? CTXL + q0 : 0);
  const int kvh = h >> 2;
  constexpr int QCOL = MODE == 0 ? COL_AQ : COL_BQ, KCOL = MODE == 0 ? COL_AK : COL_BK, VCOL = MODE == 0 ? COL_AV : COL_BV, ZCOL = MODE == 0 ? COL_AZ : COL_BZ;
  int NT, wtok;
  if (!isLat) { NT = 4; wtok = CTXL; }
  else if (MODE == 1) { NT = 36; wtok = CTXL; }
  else { const int lo = q0 - 128 < 0 ? 0 : q0 - 128, hi_ = q0 + 384 > SEQ ? SEQ : q0 + 384; wtok = CTXL + lo; NT = 4 + (hi_ - lo) / 64; }
  const bf16* Kh = (const bf16*)(p.proj + pidx(b * TPB, KCOL + kvh * 128));
  const bf16* Vh = (const bf16*)(p.proj + pidx(b * TPB, VCOL + kvh * 128));
#define KT(j) ((j) < 4 ? (j) * 64 : wtok + ((j) - 4) * 64)
  bf16* V_lds = (bf16*)lds; bf16* K_lds = (bf16*)(lds + 2 * SHM_V);
  float* ws = (float*)(lds + 2 * SHM_V + 2 * SHM_K) + wid * 64; float* li_l = ws; float* al_l = ws + 32;
  float m_reg = -1e30f, l_reg = 0; f32x16 o[4] = {}; bf16x8 qr[8];
  {
    const bf16_t* Qw = p.proj + pidx(qrow0 + wid * QBLK + r32, QCOL + h * 128) + hi * 8;
    float xf[8][8];
#pragma unroll
    for (int d0 = 0; d0 < 8; ++d0) { const bf16x8 raw = *reinterpret_cast<const bf16x8*>(Qw + d0 * 16);
#pragma unroll
      for (int j = 0; j < 8; ++j) xf[d0][j] = bf2f((bf16_t)raw[j]); }
    if (MODE == 1) {
      float ss = 0.f;
#pragma unroll
      for (int d0 = 0; d0 < 8; ++d0)
#pragma unroll
        for (int j = 0; j < 8; ++j) ss += xf[d0][j] * xf[d0][j];
      ss += __shfl_xor(ss, 32);
      const float rstd = rsqrtf(ss * (1.f / 128.f) + 1e-6f);
      const float* qn = p.b_qn + l * 128 + hi * 8;
#pragma unroll
      for (int d0 = 0; d0 < 8; ++d0) { const float4 g0 = *(const float4*)(qn + d0 * 16), g1 = *(const float4*)(qn + d0 * 16 + 4);
        xf[d0][0] *= rstd * g0.x; xf[d0][1] *= rstd * g0.y; xf[d0][2] *= rstd * g0.z; xf[d0][3] *= rstd * g0.w;
        xf[d0][4] *= rstd * g1.x; xf[d0][5] *= rstd * g1.y; xf[d0][6] *= rstd * g1.z; xf[d0][7] *= rstd * g1.w; }
    }
    if (isLat) {
      const int pos = q0 + wid * QBLK + r32;
      const float* ct = p.cos_t + pos * 64 + hi * 8; const float* st = p.sin_t + pos * 64 + hi * 8;
#pragma unroll
      for (int d0 = 0; d0 < 4; ++d0) {
        const float4 c0 = *(const float4*)(ct + d0 * 16), c1 = *(const float4*)(ct + d0 * 16 + 4), s0 = *(const float4*)(st + d0 * 16), s1 = *(const float4*)(st + d0 * 16 + 4);
        const float cc[8] = {c0.x, c0.y, c0.z, c0.w, c1.x, c1.y, c1.z, c1.w}, sn[8] = {s0.x, s0.y, s0.z, s0.w, s1.x, s1.y, s1.z, s1.w};
#pragma unroll
        for (int j = 0; j < 8; ++j) { const float x1 = xf[d0][j], x2 = xf[d0 + 4][j]; xf[d0][j] = x1 * cc[j] - x2 * sn[j]; xf[d0 + 4][j] = x2 * cc[j] + x1 * sn[j]; }
      }
    }
#pragma unroll
    for (int d0 = 0; d0 < 8; ++d0) { u32x4 w = {cvtpk(xf[d0][0], xf[d0][1]), cvtpk(xf[d0][2], xf[d0][3]), cvtpk(xf[d0][4], xf[d0][5]), cvtpk(xf[d0][6], xf[d0][7])}; qr[d0] = *reinterpret_cast<bf16x8*>(&w); }
  }
  const int sr = tid >> 4, sc = (tid & 15) * 8, vst0 = v_st(sr, sc), vst1 = v_st(32 + sr, sc);
  const int vb0 = (int)(uintptr_t)V_lds + v_rd_base(lane);
  struct { typename St::T vs0, vs1, ks0, ks1; } sr_[2];
#define SLOAD(i, k0) do { const int k0_ = (k0); sr_[i].vs0 = St::ld8(&Vh[(long)(k0_ + sr) * LDK + sc]); sr_[i].vs1 = St::ld8(&Vh[(long)(k0_ + 32 + sr) * LDK + sc]); \
    sr_[i].ks0 = St::ld8(&Kh[(long)(k0_ + sr) * LDK + sc]); sr_[i].ks1 = St::ld8(&Kh[(long)(k0_ + 32 + sr) * LDK + sc]); } while (0)
#define SWRITE(b, i) do { *(bf16x8*)((char*)V_lds + (b) * SHM_V + vst0) = St::tobf(sr_[i].vs0);          \
    *(bf16x8*)((char*)V_lds + (b) * SHM_V + vst1) = St::tobf(sr_[i].vs1); int kc = sc * 2;               \
    *(bf16x8*)((char*)K_lds + (b) * SHM_K + KSWZ(sr, kc)) = St::tobf(sr_[i].ks0);                       \
    *(bf16x8*)((char*)K_lds + (b) * SHM_K + KSWZ(32 + sr, kc)) = St::tobf(sr_[i].ks1); } while (0)
#define SWAIT() asm volatile("s_waitcnt vmcnt(4)" ::: "memory")
#define RESC(a) do { if (__any((a) < 1.f)) { if (hi == 0) al_l[r32] = (a); asm volatile("s_waitcnt lgkmcnt(0)" ::: "memory"); \
    _Pragma("unroll") for (int d = 0; d < 4; ++d) _Pragma("unroll") for (int r = 0; r < 16; ++r) o[d][r] *= al_l[crow(r, hi)]; } } while (0)
#define MASK(P0, P1, j) do { if (MODE == 0 && isLat && (j) >= 4) { const int dq_ = (q0 + wid * QBLK + r32) - (KT(j) - CTXL); \
    _Pragma("unroll") for (int r = 0; r < 16; ++r) { const int e0_ = dq_ - crow(r, hi), e1_ = e0_ - 32; \
      if (e0_ > 128 || e0_ < -128) P0[r] = -1e30f; if (e1_ > 128 || e1_ < -128) P1[r] = -1e30f; } } } while (0)
  f32x16 pA0, pA1, pB0, pB1; float mnA, mnB, alA, alB; bf16x8 pa0, pa1, pa2, pa3;
  constexpr int SE = 0, SO = 1;
  SLOAD(SE, KT(0)); asm volatile("s_waitcnt vmcnt(0)" ::: "memory"); SWRITE(0, SE); __syncthreads();
  qkt(pA0, pA1, K_lds, qr, r32, hi); partialSM(pA0, pA1, m_reg, mnA, alA);
  SLOAD(SO, KT(1)); SLOAD(SE, KT(2));
  SWAIT(); SWRITE(1, SO); __syncthreads();
  for (int j = 1; j + 1 < NT; j += 2) {
    SBAR(); qkt(pB0, pB1, (bf16*)((char*)K_lds + SHM_K), qr, r32, hi); MASK(pB0, pB1, j);
    finishSM(pA0, pA1, alA, l_reg, pa0, pa1, pa2, pa3); SBAR();
    SLOAD(SO, KT(j + 2)); SBAR();
    pv_d0(o, vb0, pa0, pa1, pa2, pa3); partialSM(pB0, pB1, m_reg, mnB, alB);
    __syncthreads(); SWAIT(); SWRITE(0, SE);
    RESC(alB); __syncthreads();
    SBAR(); qkt(pA0, pA1, K_lds, qr, r32, hi); MASK(pA0, pA1, j + 1);
    finishSM(pB0, pB1, alB, l_reg, pa0, pa1, pa2, pa3); SBAR();
    { const int jn = j + 3 < NT ? j + 3 : NT - 1; SLOAD(SE, KT(jn)); } SBAR();
    pv_d0(o, vb0 + (int)SHM_V, pa0, pa1, pa2, pa3); partialSM(pA0, pA1, m_reg, mnA, alA);
    __syncthreads(); SWAIT(); SWRITE(1, SO);
    RESC(alA); __syncthreads();
  }
  SBAR(); qkt(pB0, pB1, (bf16*)((char*)K_lds + SHM_K), qr, r32, hi); MASK(pB0, pB1, NT - 1);
  finishSM(pA0, pA1, alA, l_reg, pa0, pa1, pa2, pa3); SBAR();
  pv_d0(o, vb0, pa0, pa1, pa2, pa3); partialSM(pB0, pB1, m_reg, mnB, alB);
  __syncthreads(); RESC(alB);
  finishSM(pB0, pB1, alB, l_reg, pa0, pa1, pa2, pa3); SBAR();
  pv_d0(o, vb0 + (int)SHM_V, pa0, pa1, pa2, pa3);
  if (MODE == 0) { constexpr float C = SCALE * 1.4426950408889634f; l_reg += __builtin_amdgcn_exp2f(p.a_sink[l * 8 + h] * 1.4426950408889634f - m_reg * C); }
  if (hi == 0) li_l[r32] = l_reg; asm volatile("s_waitcnt lgkmcnt(0)" ::: "memory");
  float rli[16];
#pragma unroll
  for (int r = 0; r < 16; ++r) rli[r] = __builtin_amdgcn_rcpf(li_l[crow(r, hi)]);
  __syncthreads();
  { float* Os = (float*)(lds + wid * 16384);
#pragma unroll
    for (int r = 0; r < 16; ++r) { const int orow = crow(r, hi);
#pragma unroll
      for (int d0 = 0; d0 < 4; ++d0) Os[orow * 128 + d0 * 32 + r32] = o[d0][r] * rli[r]; }
    const bf16_t* Zb = p.proj + pidx(qrow0 + wid * QBLK, ZCOL + h * 128);
    bf16_t* Ob = p.gin + (size_t)(qrow0 + wid * QBLK) * 3072 + MODE * 1024 + h * 128;
    bf16x8 zv[8];
#pragma unroll
    for (int i = 0; i < 8; ++i) zv[i] = *reinterpret_cast<const bf16x8*>(Zb + (i * 64 + lane) * 8);
#pragma unroll
    for (int i = 0; i < 8; ++i) { const int ch = i * 64 + lane, row = ch >> 4, c8 = (ch & 15) * 8;
      const f32x8 ov = *reinterpret_cast<const f32x8*>(Os + row * 128 + c8);
      float g[8];
#pragma unroll
      for (int j = 0; j < 8; ++j) g[j] = ov[j] * silu_fast(bf2f((bf16_t)zv[i][j]));
      u32x4 wv = {cvtpk2(g[0], g[1]), cvtpk2(g[2], g[3]), cvtpk2(g[4], g[5]), cvtpk2(g[6], g[7])};
      *reinterpret_cast<u32x4*>(Ob + (size_t)row * 3072 + c8) = wv; }
  }
  __syncthreads();
#undef KT
#undef SLOAD
#undef SWRITE
#undef SWAIT
#undef RESC
#undef MASK
}
}

namespace hg {
using att::bf16x8; using att::f32x16; using att::crow;
typedef unsigned u32x2 __attribute__((ext_vector_type(2)));
typedef unsigned u32x4_ __attribute__((ext_vector_type(4)));
constexpr int RS = 272, RS2 = 144;
constexpr int O_QD = 0, O_KD = O_QD + 64 * RS, O_QO = O_KD + 64 * RS, O_KO = O_QO + 32 * RS, O_QS = O_KO + 32 * RS, O_KST = O_QS + 64 * RS, O_VT = O_KST + 128 * RS2,
              O_P = O_VT + 64 * RS2, O_SBT = O_P + 64 * RS2, O_SEG = O_SBT + 64 * RS, O_ETOT = O_SEG + 4096, O_END = O_ETOT + 512;
static_assert(O_END <= LDS_BYTES, "hgrn LDS");
__device__ __forceinline__ bf16x8 ldf(const unsigned char* base, int row, int rs, int kk, int hi) { return *reinterpret_cast<const bf16x8*>(base + row * rs + (kk * 16 + hi * 8) * 2); }

__device__ __forceinline__ void hgrn_item(const Params& p, int l, int item, unsigned char* lds) {
  const int tid = tidx(), w = __builtin_amdgcn_readfirstlane(tid >> 6), lane = tid & 63, r32 = lane & 31, hi = lane >> 5;
  const int vh = item & 1, dir = (item >> 1) & 1, h = (item >> 2) & 7, b = item >> 5;
  const bf16_t* projb = p.proj + (size_t)b * TPB * 128;
  const size_t qcol = pidx(0, COL_CQ + h * 128) + 2 * lane, zcol = pidx(0, (dir ? COL_CZB : COL_CZF) + h * 128) + 2 * lane, vcol = pidx(0, COL_CI + h * 128) + vh * 64;
  const float2 lbk = *reinterpret_cast<const float2*>(p.lbv + (l * 2 + dir) * 1024 + h * 128 + 2 * lane);
  const float oml0 = 1.f - lbk.x, oml1 = 1.f - lbk.y;
  const int vs = lane, vc = w * 8;
  unsigned char* Qd = lds + O_QD; unsigned char* Kd = lds + O_KD; unsigned char* Qo = lds + O_QO; unsigned char* Ko = lds + O_KO; unsigned char* Qs = lds + O_QS;
  unsigned char* KsT = lds + O_KST; unsigned char* VT = lds + O_VT; unsigned char* P = lds + O_P; unsigned char* SbT = lds + O_SBT;
  float* segtot = (float*)(lds + O_SEG); float* etot = (float*)(lds + O_ETOT);
  for (int i = tid; i < 64 * RS / 4; i += 512) ((unsigned*)SbT)[i] = 0u;
  f32x16 Sacc = {};
  const int sgn = dir ? -1 : 1;
  unsigned zzA[8], qqA[8], zzB[8], qqB[8]; bf16x8 vrA, vrB;
  float* od = p.pbuf + (size_t)dir * TT * 1024 + (size_t)b * TPB * 1024 + h * 128 + vh * 64;
  constexpr float L2E = 1.4426950408889634f, QS = 0.088388347648318440f;
#define CHBASE(c) (dir ? ((c) < 4 ? 255 - 64 * (c) : 2303 - 64 * ((c) - 4)) : 64 * (c))
#define LOADCH(c, ZZ, QQ, VR) do { const int pb_ = CHBASE(c); \
    _Pragma("unroll") for (int i = 0; i < 8; ++i) { const bf16_t* rp_ = projb + (size_t)(pb_ + sgn * (8 * w + i)) * 128; ZZ[i] = *reinterpret_cast<const unsigned*>(rp_ + zcol); QQ[i] = *reinterpret_cast<const unsigned*>(rp_ + qcol); } \
    VR = *reinterpret_cast<const bf16x8*>(projb + (size_t)(pb_ + sgn * vs) * 128 + vcol + vc); } while (0)
  LOADCH(0, zzA, qqA, vrA); LOADCH(1, zzB, qqB, vrB);
  float cu0[8], cu1[8], kk0[8], kk1[8];
  auto a1 = [&](const unsigned (&zz)[8]) __attribute__((always_inline)) {
    float run0 = 0.f, run1 = 0.f;
#pragma unroll
    for (int i = 0; i < 8; ++i) {
      const float z0 = fmaxf(__uint_as_float(zz[i] << 16), -60.f), z1 = fmaxf(__uint_as_float(zz[i] & 0xffff0000u), -60.f);
      const float e0 = __builtin_amdgcn_exp2f(-z0 * L2E), e1 = __builtin_amdgcn_exp2f(-z1 * L2E);
      const float s0 = __builtin_amdgcn_rcpf(1.f + e0), s1 = __builtin_amdgcn_rcpf(1.f + e1);
      run0 += __builtin_amdgcn_logf(lbk.x + oml0 * s0); run1 += __builtin_amdgcn_logf(lbk.y + oml1 * s1);
      cu0[i] = run0; cu1[i] = run1; kk0[i] = oml0 * e0 * s0; kk1[i] = oml1 * e1 * s1; }
    *reinterpret_cast<float2*>(segtot + w * 128 + 2 * lane) = make_float2(run0, run1);
  };
  a1(zzA);
  __syncthreads();
  auto body = [&](const int c, unsigned (&zz)[8], unsigned (&qq)[8], bf16x8& vr, const unsigned (&nzz)[8]) __attribute__((always_inline)) {
    const int pbase = CHBASE(c);
    { float2 sg[8];
#pragma unroll
      for (int j = 0; j < 8; ++j) sg[j] = *reinterpret_cast<const float2*>(segtot + j * 128 + 2 * lane);
      float pre0 = 0.f, pre1 = 0.f;
#pragma unroll
      for (int j = 0; j < 8; ++j) { if (j < w) { pre0 += sg[j].x; pre1 += sg[j].y; } }
      const float a15 = sg[0].x + sg[1].x, a31 = a15 + sg[2].x + sg[3].x, a47 = a31 + sg[4].x + sg[5].x, atot = a47 + sg[6].x + sg[7].x;
      const float b15 = sg[0].y + sg[1].y, b31 = b15 + sg[2].y + sg[3].y, b47 = b31 + sg[4].y + sg[5].y, btot = b47 + sg[6].y + sg[7].y;
      const bool lo = w < 4;
      const float ra = lo ? a15 : a47, rb = lo ? b15 : b47;
      const float cOa = __builtin_amdgcn_exp2f(lo ? a31 - ra : ra - a31), cOb = __builtin_amdgcn_exp2f(lo ? b31 - rb : rb - b31);
      const float cSa = __builtin_amdgcn_exp2f(ra), cSb = __builtin_amdgcn_exp2f(rb);
      const float cTa = __builtin_amdgcn_exp2f(atot - ra), cTb = __builtin_amdgcn_exp2f(btot - rb);
      if (w == 0) *reinterpret_cast<float2*>(etot + 2 * lane) = make_float2(__builtin_amdgcn_exp2f(atot), __builtin_amdgcn_exp2f(btot));
      float ks0[8], ks1[8];
#pragma unroll
      for (int i = 0; i < 8; ++i) { const int t = 8 * w + i;
        const float d0 = cu0[i] + pre0 - ra, d1 = cu1[i] + pre1 - rb;
        const float ea = __builtin_amdgcn_exp2f(fminf(d0, 115.f)), eb = __builtin_amdgcn_exp2f(fminf(d1, 115.f));
        const float ia = __builtin_amdgcn_exp2f(fminf(-d0, 115.f)), ib = __builtin_amdgcn_exp2f(fminf(-d1, 115.f));
        const float q0 = __uint_as_float(qq[i] << 16) * QS, q1 = __uint_as_float(qq[i] & 0xffff0000u) * QS;
        const float qa = q0 * ea, qb = q1 * eb, ka = kk0[i] * ia, kb = kk1[i] * ib;
        *reinterpret_cast<unsigned*>(Qd + t * RS + lane * 4) = cvtpk2(qa, qb);
        *reinterpret_cast<unsigned*>(Kd + t * RS + lane * 4) = cvtpk2(ka, kb);
        if (lo) *reinterpret_cast<unsigned*>(Ko + t * RS + lane * 4) = cvtpk2(ka * cOa, kb * cOb);
        else    *reinterpret_cast<unsigned*>(Qo + (t - 32) * RS + lane * 4) = cvtpk2(qa * cOa, qb * cOb);
        *reinterpret_cast<unsigned*>(Qs + t * RS + lane * 4) = cvtpk2(q0 * (ea * cSa), q1 * (eb * cSb));
        ks0[i] = kk0[i] * (ia * cTa); ks1[i] = kk1[i] * (ib * cTb); }
      const u32x4_ w0 = {cvtpk2(ks0[0], ks0[1]), cvtpk2(ks0[2], ks0[3]), cvtpk2(ks0[4], ks0[5]), cvtpk2(ks0[6], ks0[7])};
      const u32x4_ w1 = {cvtpk2(ks1[0], ks1[1]), cvtpk2(ks1[2], ks1[3]), cvtpk2(ks1[4], ks1[5]), cvtpk2(ks1[6], ks1[7])};
      *reinterpret_cast<u32x4_*>(KsT + (2 * lane) * RS2 + w * 16) = w0; *reinterpret_cast<u32x4_*>(KsT + (2 * lane + 1) * RS2 + w * 16) = w1; }
#pragma unroll
    for (int j = 0; j < 8; ++j) ((bf16_t*)VT)[(vc + j) * (RS2 / 2) + vs] = (bf16_t)vr[j];
    if (c + 2 < 36) LOADCH(c + 2, zz, qq, vr);
    __syncthreads();
    f32x16 oacc = {};
    const int tb = (w - 4) >> 1, vb = (w - 4) & 1;
    if (w < 3) {
      const unsigned char* Asrc = w == 2 ? Ko : Kd + (32 * w) * RS; const unsigned char* Bsrc = w == 2 ? Qo : Qd + (32 * w) * RS;
      f32x16 acc = {};
#pragma unroll
      for (int q = 0; q < 8; ++q) acc = __builtin_amdgcn_mfma_f32_32x32x16_bf16(ldf(Asrc, r32, RS, q, hi), ldf(Bsrc, r32, RS, q, hi), acc, 0, 0, 0);
      const int trow = (w == 0 ? 0 : 32) + r32, scol0 = (w == 1 ? 32 : 0);
#pragma unroll
      for (int g = 0; g < 4; ++g) { const int s0 = 8 * g + 4 * hi; float v0 = acc[4 * g], v1 = acc[4 * g + 1], v2 = acc[4 * g + 2], v3 = acc[4 * g + 3];
        if (w < 2) { v0 = (s0 <= r32) ? v0 : 0.f; v1 = (s0 + 1 <= r32) ? v1 : 0.f; v2 = (s0 + 2 <= r32) ? v2 : 0.f; v3 = (s0 + 3 <= r32) ? v3 : 0.f; }
        u32x2 pk = {cvtpk2(v0, v1), cvtpk2(v2, v3)}; *reinterpret_cast<u32x2*>(P + trow * RS2 + (scol0 + s0) * 2) = pk; }
    } else if (w >= 4) {
#pragma unroll
      for (int q = 0; q < 8; ++q) oacc = __builtin_amdgcn_mfma_f32_32x32x16_bf16(ldf(Qs, 32 * tb + r32, RS, q, hi), ldf(SbT, 32 * vb + r32, RS, q, hi), oacc, 0, 0, 0);
    }
    __syncthreads();
    if (w >= 4) {
      const int nks = tb == 0 ? 2 : 4;
      for (int q = 0; q < nks; ++q) oacc = __builtin_amdgcn_mfma_f32_32x32x16_bf16(ldf(P, 32 * tb + r32, RS2, q, hi), ldf(VT, 32 * vb + r32, RS2, q, hi), oacc, 0, 0, 0);
#pragma unroll
      for (int r = 0; r < 16; ++r) { const int t = 32 * tb + crow(r, hi); od[(size_t)(pbase + sgn * t) * 1024 + 32 * vb + r32] = oacc[r]; }
    }
    { const int kb = w >> 1, vb2 = w & 1;
#pragma unroll
      for (int r = 0; r < 16; ++r) Sacc[r] *= etot[32 * kb + crow(r, hi)];
#pragma unroll
      for (int q = 0; q < 4; ++q) Sacc = __builtin_amdgcn_mfma_f32_32x32x16_bf16(ldf(KsT, 32 * kb + r32, RS2, q, hi), ldf(VT, 32 * vb2 + r32, RS2, q, hi), Sacc, 0, 0, 0);
#pragma unroll
      for (int g = 0; g < 4; ++g) { u32x2 pk = {cvtpk2(Sacc[4 * g], Sacc[4 * g + 1]), cvtpk2(Sacc[4 * g + 2], Sacc[4 * g + 3])};
        *reinterpret_cast<u32x2*>(SbT + (32 * vb2 + r32) * RS + (32 * kb + 8 * g + 4 * hi) * 2) = pk; } }
    if (c + 1 < 36) a1(nzz);
    __syncthreads();
  };
  for (int c = 0; c < 36; c += 2) { body(c, zzA, qqA, vrA, zzB); body(c + 1, zzB, qqB, vrB, zzA); }
#undef CHBASE
#undef LOADCH
}
}

struct Order {
    int nM, nN, nwg, G, c, rep, skipctx, tail;
    __device__ void init(int nM_, int nN_, int rep_, int skipctx_, int G_, int c_) { nM = nM_; nN = nN_; nwg = nM * nN; G = G_; c = c_; rep = rep_; skipctx = skipctx_; tail = 0; }
    __device__ bool next(int i, pg8::Unit& u) const {
        const int tr = rep == 3 ? i / 3 : i, xb = rep == 3 ? i - 3 * tr : 0;
        const long L = (long)tr * G + c;
        if (L >= nwg) { const int r = (int)(L - nwg); if (r >= tail) return false;
            const int k = r & 15; u.pm = (r >> 4) * 9; u.pn = k < 2 ? 4 + k : (k < 4 ? 12 + k : 20 + k); return true; }
        int wgid = (int)L; { const int q = nwg / pg8::NXCD, r = nwg % pg8::NXCD, xcd = wgid % pg8::NXCD, off = wgid / pg8::NXCD; wgid = (xcd < r ? xcd * (q + 1) : r * (q + 1) + (xcd - r) * q) + off; }
        const int nig = pg8::WGM * nN, gid = wgid / nig, fm = gid * pg8::WGM, gsz = (nM - fm) < pg8::WGM ? (nM - fm) : pg8::WGM;
        int pm = fm + ((wgid % nig) % gsz); const int pn = (wgid % nig) / gsz;
        if (skipctx) pm = pm + pm / 8 + 1;
        u.pm = pm + 72 * xb; u.pn = pn + 8 * xb; return true;
    }
    __device__ __forceinline__ void a_ready(const pg8::Unit&) const {}
    __device__ __forceinline__ void done(const pg8::Unit&) const {}
};
typedef float f32x4_ __attribute__((ext_vector_type(4)));
typedef unsigned u32x4_ __attribute__((ext_vector_type(4)));
typedef short s16x8_ __attribute__((ext_vector_type(8)));
struct EpiProj {
    static constexpr bool PERM = true, AFTER_DRAIN = false, HAS_MID = false;
    bf16_t* O;
    __device__ __forceinline__ void operator()(const pg8::f32x4 (&acc)[2][2][4][2], const pg8::Unit& u, int wr, int wc, int fr, int fq) const {
        int row0 = u.pm * 256 + wr * 64 + fr, col0 = u.pn * 256 + wc * 32 + 8 * fq;
        asm volatile("" : "+v"(row0), "+v"(col0));
        const bool gate = u.pn >= COL_GATE / 256;
#pragma unroll
        for (int ai = 0; ai < 2; ++ai)
#pragma unroll
            for (int m = 0; m < 4; ++m) { bf16_t* rowp = O + pidx(row0 + ai * 128 + m * 16, col0);
#pragma unroll
                for (int bj = 0; bj < 2; ++bj) { pg8::f32x4 v0 = acc[ai][bj][m][0], v1 = acc[ai][bj][m][1];
                    if (gate) {
#pragma unroll
                        for (int j = 0; j < 4; ++j) { v0[j] = 1.f + __expf(fminf(-v0[j], 80.f)); v1[j] = 1.f + __expf(fminf(-v1[j], 80.f)); } }
                    const u32x4_ w = {cvtpk2(v0[0], v0[1]), cvtpk2(v0[2], v0[3]), cvtpk2(v1[0], v1[1]), cvtpk2(v1[2], v1[3])};
                    *reinterpret_cast<u32x4_*>(rowp + (size_t)bj * TT * 128) = w; } }
    }
};
struct EpiBranch {
    static constexpr bool PERM = true, AFTER_DRAIN = false, HAS_MID = true;
    const bf16_t* proj; bf16_t* merged;
    __device__ __forceinline__ void mid(pg8::f32x4 (&acc)[2][2][4][2], const pg8::Unit& u, int t, int wr, int wc, int fr, int fq) const {
        const int xb = (t >> 4) - 1;
        int row0 = u.pm * 256 + wr * 64 + fr, col0 = u.pn * 256 + wc * 32 + 8 * fq;
        asm volatile("" : "+v"(row0), "+v"(col0));
#pragma unroll
        for (int b0 = 0; b0 < 16; b0 += 6) {
            s16x8_ ga[6], gb[6];
#pragma unroll
            for (int k = 0; k < 6; ++k) { const int q = b0 + k;
                if (q < 16) { const int ai = q >> 3, bj = (q >> 2) & 1, m = q & 3; const int row = row0 + ai * 128 + m * 16, col = col0 + bj * 128;
                    ga[k] = *reinterpret_cast<const s16x8_*>(proj + pidx(row, COL_GATE + xb * 2048 + col));
                    gb[k] = *reinterpret_cast<const s16x8_*>(proj + pidx(row, COL_GATE + (xb + 1) * 2048 + col)); } }
            asm volatile("" ::: "memory");
#pragma unroll
            for (int k = 0; k < 6; ++k) { const int q = b0 + k;
                if (q < 16) { const int ai = q >> 3, bj = (q >> 2) & 1, m = q & 3;
#pragma unroll
                    for (int j = 0; j < 4; ++j) {
                        acc[ai][bj][m][0][j] *= bf2f((bf16_t)gb[k][j]) * __builtin_amdgcn_rcpf(bf2f((bf16_t)ga[k][j]));
                        acc[ai][bj][m][1][j] *= bf2f((bf16_t)gb[k][4 + j]) * __builtin_amdgcn_rcpf(bf2f((bf16_t)ga[k][4 + j])); } } }
        }
    }
    __device__ __forceinline__ void operator()(const pg8::f32x4 (&acc)[2][2][4][2], const pg8::Unit& u, int wr, int wc, int fr, int fq) const {
        int row0 = u.pm * 256 + wr * 64 + fr, col0 = u.pn * 256 + wc * 32 + 8 * fq;
        asm volatile("" : "+v"(row0), "+v"(col0));
#pragma unroll
        for (int ai = 0; ai < 2; ++ai) {
            s16x8_ gzs[4][2];
#pragma unroll
            for (int m = 0; m < 4; ++m)
#pragma unroll
                for (int bj = 0; bj < 2; ++bj) gzs[m][bj] = *reinterpret_cast<const s16x8_*>(proj + pidx(row0 + ai * 128 + m * 16, COL_GATE + 2 * 2048 + col0 + bj * 128));
#pragma unroll
            for (int m = 0; m < 4; ++m) { const int row = row0 + ai * 128 + m * 16;
#pragma unroll
                for (int bj = 0; bj < 2; ++bj) { const int col = col0 + bj * 128;
                    const s16x8_ gz = gzs[m][bj];
                    const pg8::f32x4 v0 = acc[ai][bj][m][0], v1 = acc[ai][bj][m][1];
                    f32x4_ r0, r1;
#pragma unroll
                    for (int j = 0; j < 4; ++j) { r0[j] = v0[j] * __builtin_amdgcn_rcpf(bf2f((bf16_t)gz[j])); r1[j] = v1[j] * __builtin_amdgcn_rcpf(bf2f((bf16_t)gz[4 + j])); }
                    const u32x4_ w = {cvtpk2(r0[0], r0[1]), cvtpk2(r0[2], r0[3]), cvtpk2(r1[0], r1[1]), cvtpk2(r1[2], r1[3])};
                    *reinterpret_cast<u32x4_*>(merged + (size_t)row * DM + col) = w; } } }
    }
};
struct EpiOut {
    static constexpr bool PERM = true, AFTER_DRAIN = false, HAS_MID = false;
    const float* x; const float* ctx; float* resid; const float* modl; int layer0;
    __device__ __forceinline__ void operator()(const pg8::f32x4 (&acc)[2][2][4][2], const pg8::Unit& u, int wr, int wc, int fr, int fq) const {
        const int pm = u.pm, b = pm / 9, pc = pm - 9 * b;
        int rin0 = wr * 64 + fr, col0 = u.pn * 256 + wc * 32 + 8 * fq;
        asm volatile("" : "+v"(rin0), "+v"(col0));
        const float* gt = modl + (size_t)(pc == 0 ? 8 : b) * 6144 + 4096;
        const float* srcp = layer0 ? (pc == 0 ? ctx + (size_t)b * CTXL * DM : x + ((size_t)b * SEQ + (pc - 1) * 256) * DM) : resid + (size_t)pm * 256 * DM;
        float* dstp = resid + (size_t)pm * 256 * DM;
#pragma unroll
        for (int bj = 0; bj < 2; ++bj) { const int col = col0 + bj * 128;
            const f32x4_ g0 = *reinterpret_cast<const f32x4_*>(gt + col), g1 = *reinterpret_cast<const f32x4_*>(gt + col + 4);
#pragma unroll
            for (int ai = 0; ai < 2; ++ai) {
                f32x4_ s0[4], s1[4];
#pragma unroll
                for (int m = 0; m < 4; ++m) { const size_t ro = (size_t)(rin0 + ai * 128 + m * 16) * DM + col;
                    s0[m] = *reinterpret_cast<const f32x4_*>(srcp + ro); s1[m] = *reinterpret_cast<const f32x4_*>(srcp + ro + 4); }
#pragma unroll
                for (int m = 0; m < 4; ++m) { const size_t ro = (size_t)(rin0 + ai * 128 + m * 16) * DM + col;
                    const pg8::f32x4 v0 = acc[ai][bj][m][0], v1 = acc[ai][bj][m][1];
                    f32x4_ r0, r1;
#pragma unroll
                    for (int j = 0; j < 4; ++j) { r0[j] = s0[m][j] + g0[j] * v0[j]; r1[j] = s1[m][j] + g1[j] * v1[j]; }
                    *reinterpret_cast<f32x4_*>(dstp + ro) = r0; *reinterpret_cast<f32x4_*>(dstp + ro + 4) = r1; } } }
    }
};

__device__ __forceinline__ void ph_prologue(const Params& p, unsigned char* lds) {
    const int tid = tidx(), G = gridDim.x, wg = blockIdx.x, w = tid >> 6, lane = tid & 63;
    if (wg < 192) {
        float* sc = (float*)lds; float* red = sc + 9 * 2048;
        for (int i = tid; i < 9 * 2048; i += 512) { const int r = i >> 11, k = i & 2047; const float v = r < 8 ? p.c[r * 2048 + k] : p.c_ctx[k]; sc[i] = siluf_(v); }
        __syncthreads();
        for (int item = wg; item < 192; item += G) {
            const int l = item / 48, n0 = (item - l * 48) * 128;
            const float* wp = p.ada_w + ((size_t)l * 2048 + w * 256) * 6144 + n0 + lane * 2;
            const float* sp = sc + w * 256;
            float a0[9], a1[9];
#pragma unroll
            for (int r = 0; r < 9; ++r) { a0[r] = 0.f; a1[r] = 0.f; }
#pragma unroll 8
            for (int k = 0; k < 256; ++k) { const float2 wv = *reinterpret_cast<const float2*>(wp + (size_t)k * 6144);
#pragma unroll
                for (int r = 0; r < 9; ++r) { const float s = sp[r * 2048 + k]; a0[r] += s * wv.x; a1[r] += s * wv.y; } }
#pragma unroll
            for (int r = 0; r < 9; ++r) { red[(w * 9 + r) * 128 + lane * 2] = a0[r]; red[(w * 9 + r) * 128 + lane * 2 + 1] = a1[r]; }
            __syncthreads();
            for (int i = tid; i < 9 * 128; i += 512) { const int r = i >> 7, n = i & 127; float s = 0.f;
#pragma unroll
                for (int w2 = 0; w2 < 8; ++w2) s += red[(w2 * 9 + r) * 128 + n];
                p.mod[((size_t)l * 9 + r) * 6144 + n0 + n] = s + p.ada_b[l * 6144 + n0 + n]; }
            __syncthreads();
        }
    }
    {
        __syncthreads();
        float* tile = (float*)lds;
        constexpr int T_IN = 4 * 32 * 256, T_BR = 12 * 16 * 32, T_OUT = 4 * 32 * 32, T_ALL = T_IN + T_BR + T_OUT;
        const int rr0 = tid >> 4, c4 = (tid & 15) * 4, kg = tid & 7, nn = tid >> 3;
        auto decode = [&](int t, const float*& srcp, bf16_t*& dstp, int& ldd) __attribute__((always_inline)) {
            const float* src; bf16_t* dst; int K, N, kt, nt;
            if (t < T_IN) { const int l = t / 8192, r = t - l * 8192; K = 2048; N = 16384; kt = r / 256; nt = r - kt * 256; src = p.w_in + (size_t)l * K * N; dst = p.WinT + (size_t)l * K * N; ldd = K; }
            else if (t < T_IN + T_BR) { const int t2 = t - T_IN, lx = t2 / 512, r = t2 - lx * 512, l = lx / 3, xb = lx - 3 * l; K = 1024; N = 2048; kt = r / 32; nt = r - kt * 32;
                src = (xb == 0 ? p.w_ba : (xb == 1 ? p.w_bb : p.w_bc)) + (size_t)l * K * N; dst = p.WbT + (size_t)l * 3 * K * N + xb * 1024; ldd = 3072; }
            else { const int t2 = t - T_IN - T_BR, l = t2 / 1024, r = t2 - l * 1024; K = 2048; N = 2048; kt = r / 32; nt = r - kt * 32; src = p.w_out + (size_t)l * K * N; dst = p.WoT + (size_t)l * K * N; ldd = K; }
            srcp = src + (size_t)(kt * 64 + rr0) * N + nt * 64 + c4;
            dstp = dst + (size_t)(nt * 64 + nn) * ldd + kt * 64 + kg * 8;
            return N;
        };
        const float* srcp; bf16_t* dstp; int ldd; int N = 0; float4 va = make_float4(0.f, 0.f, 0.f, 0.f), vb = va;
        int t = wg; if (t < T_ALL) { N = decode(t, srcp, dstp, ldd); va = *reinterpret_cast<const float4*>(srcp); vb = *reinterpret_cast<const float4*>(srcp + (size_t)32 * N); }
        for (int it = 0; t < T_ALL; t += G, ++it) {
            float* tb = tile + (it & 1) * (64 * 65);
            tb[rr0 * 65 + c4] = va.x; tb[rr0 * 65 + c4 + 1] = va.y; tb[rr0 * 65 + c4 + 2] = va.z; tb[rr0 * 65 + c4 + 3] = va.w;
            tb[(rr0 + 32) * 65 + c4] = vb.x; tb[(rr0 + 32) * 65 + c4 + 1] = vb.y; tb[(rr0 + 32) * 65 + c4 + 2] = vb.z; tb[(rr0 + 32) * 65 + c4 + 3] = vb.w;
            __syncthreads();
            bf16_t* dcur = dstp;
            if (t + G < T_ALL) { N = decode(t + G, srcp, dstp, ldd); va = *reinterpret_cast<const float4*>(srcp); vb = *reinterpret_cast<const float4*>(srcp + (size_t)32 * N); }
            float v[8];
#pragma unroll
            for (int j = 0; j < 8; ++j) v[j] = tb[(kg * 8 + j) * 65 + nn];
            const u32x4_ wv = {cvtpk2(v[0], v[1]), cvtpk2(v[2], v[3]), cvtpk2(v[4], v[5]), cvtpk2(v[6], v[7])};
            *reinterpret_cast<u32x4_*>(dcur) = wv;
        }
        __syncthreads();
    }
    for (int i = wg * 512 + tid; i < SEQ * 64; i += G * 512) { const int pos = i >> 6, d = i & 63, fi = d & 31; const int base = d < 32 ? (pos >> 6) : (pos & 63);
        const float inv = powf(10000.f, -(float)fi / 32.f); const float ang = (float)base * inv; p.cos_t[i] = cosf(ang); p.sin_t[i] = sinf(ang); }
    for (int i = wg * 512 + tid; i < 2048; i += G * 512) { const float x0 = p.clb[i], x1 = p.clb[2048 + i], x2 = p.clb[4096 + i], x3 = p.clb[6144 + i];
        const float mx = fmaxf(fmaxf(x0, x1), fmaxf(x2, x3)); const float e0 = expf(x0 - mx), e1 = expf(x1 - mx), e2 = expf(x2 - mx), e3 = expf(x3 - mx); const float inv = 1.f / (e0 + e1 + e2 + e3);
        p.lbv[i] = 0.f; p.lbv[2048 + i] = e1 * inv; p.lbv[4096 + i] = (e1 + e2) * inv; p.lbv[6144 + i] = (e1 + e2 + e3) * inv; }
}

__device__ __forceinline__ void ph_norm(const Params& p, int l) {
    const int tid = tidx(), w = tid >> 6, lane = tid & 63;
    const float* g = p.norm_g + l * DM;
    const int nwv = gridDim.x * 8, per = (TT + nwv - 1) / nwv, gw = blockIdx.x * 8 + w;
    const int r0 = gw * per, r1 = (r0 + per < TT) ? r0 + per : TT;
    auto rowsrc = [&](int row) __attribute__((always_inline)) -> const float* { const int b = row / TPB, pp = row - b * TPB;
        return l == 0 ? (pp < CTXL ? p.ctx + ((size_t)b * CTXL + pp) * DM : p.x + ((size_t)b * SEQ + pp - CTXL) * DM) : p.resid + (size_t)row * DM; };
    float4 v[8], vn[8], gv[8], sh[8], sc[8];
#pragma unroll
    for (int i = 0; i < 8; ++i) gv[i] = *reinterpret_cast<const float4*>(g + i * 256 + lane * 4);
    int cur_mr = -1;
    if (r0 < r1) { const float* src = rowsrc(r0);
#pragma unroll
        for (int i = 0; i < 8; ++i) v[i] = *reinterpret_cast<const float4*>(src + i * 256 + lane * 4); }
    for (int row = r0; row < r1; ++row) {
        const int b = row / TPB, pp = row - b * TPB, mr = pp < CTXL ? 8 : b;
        if (row + 1 < r1) { const float* srcn = rowsrc(row + 1);
#pragma unroll
            for (int i = 0; i < 8; ++i) vn[i] = *reinterpret_cast<const float4*>(srcn + i * 256 + lane * 4); }
        if (mr != cur_mr) { cur_mr = mr; const float* md = p.mod + ((size_t)l * 9 + mr) * 6144;
#pragma unroll
            for (int i = 0; i < 8; ++i) { sh[i] = *reinterpret_cast<const float4*>(md + i * 256 + lane * 4); sc[i] = *reinterpret_cast<const float4*>(md + 2048 + i * 256 + lane * 4); } }
        float ss = 0.f;
#pragma unroll
        for (int i = 0; i < 8; ++i) ss += v[i].x * v[i].x + v[i].y * v[i].y + v[i].z * v[i].z + v[i].w * v[i].w;
        ss = wave_sum(ss);
        const float rstd = rsqrtf(ss * (1.f / DM) + 1e-6f);
#pragma unroll
        for (int i = 0; i < 8; ++i) { const int col = i * 256 + lane * 4;
            const float y0 = v[i].x * rstd * gv[i].x * (1.f + sc[i].x) + sh[i].x, y1 = v[i].y * rstd * gv[i].y * (1.f + sc[i].y) + sh[i].y;
            const float y2 = v[i].z * rstd * gv[i].z * (1.f + sc[i].z) + sh[i].z, y3 = v[i].w * rstd * gv[i].w * (1.f + sc[i].w) + sh[i].w;
            uint2 o; o.x = cvtpk2(y0, y1); o.y = cvtpk2(y2, y3);
            *reinterpret_cast<uint2*>(p.hbuf + (size_t)row * DM + col) = o; }
#pragma unroll
        for (int i = 0; i < 8; ++i) v[i] = vn[i];
    }
}

__device__ __forceinline__ void ph_kfix(const Params& p, int l) {
    const int tid = tidx(), w = tid >> 6, lane = tid & 63;
    const float g1 = p.b_kn[l * 128 + lane], g2 = p.b_kn[l * 128 + 64 + lane];
    const int stride = gridDim.x * 8;
    int row = blockIdx.x * 8 + w;
    bf16_t r1[4], r2[4], n1[4], n2[4]; float cs = 1.f, sn = 0.f, csn = 1.f, snn = 0.f;
#define KF_LOAD(ROW, A1, A2, CS, SN) do { const int b_ = (ROW) / TPB, pp_ = (ROW) - b_ * TPB; \
    _Pragma("unroll") for (int hh = 0; hh < 4; ++hh) { const bf16_t* kp_ = p.proj + pidx((ROW), hh < 2 ? COL_AK + hh * 128 : COL_BK + (hh - 2) * 128); A1[hh] = kp_[lane]; A2[hh] = kp_[64 + lane]; } \
    CS = 1.f; SN = 0.f; if (pp_ >= CTXL) { CS = p.cos_t[(pp_ - CTXL) * 64 + lane]; SN = p.sin_t[(pp_ - CTXL) * 64 + lane]; } } while (0)
    if (row < TT) KF_LOAD(row, r1, r2, cs, sn);
    for (; row < TT; row += stride) {
        const int b = row / TPB, pp = row - b * TPB; const bool lat = pp >= CTXL;
        if (row + stride < TT) KF_LOAD(row + stride, n1, n2, csn, snn);
        float x1[4], x2[4];
#pragma unroll
        for (int hh = 0; hh < 4; ++hh) { x1[hh] = bf2f(r1[hh]); x2[hh] = bf2f(r2[hh]); }
        float ssa = x1[2] * x1[2] + x2[2] * x2[2], ssb = x1[3] * x1[3] + x2[3] * x2[3];
#pragma unroll
        for (int o = 32; o >= 1; o >>= 1) { ssa += __shfl_xor(ssa, o); ssb += __shfl_xor(ssb, o); }
        const float ra = rsqrtf(ssa * (1.f / 128.f) + 1e-6f), rb = rsqrtf(ssb * (1.f / 128.f) + 1e-6f);
        x1[2] *= ra * g1; x2[2] *= ra * g2; x1[3] *= rb * g1; x2[3] *= rb * g2;
#pragma unroll
        for (int hh = 0; hh < 4; ++hh) {
            if (hh < 2 && !lat) continue;
            bf16_t* kp = p.proj + pidx(row, hh < 2 ? COL_AK + hh * 128 : COL_BK + (hh - 2) * 128);
            const float y1 = x1[hh] * cs - x2[hh] * sn, y2 = x2[hh] * cs + x1[hh] * sn;
            kp[lane] = f2bf(y1); kp[64 + lane] = f2bf(y2); }
#pragma unroll
        for (int hh = 0; hh < 4; ++hh) { r1[hh] = n1[hh]; r2[hh] = n2[hh]; }
        cs = csn; sn = snn;
    }
#undef KF_LOAD
}

__device__ __forceinline__ void ph_ccomb(const Params& p, int l) {
    const int tid = tidx(), w = tid >> 6, lane = tid & 63;
    const float2 gn = *reinterpret_cast<const float2*>(p.c_gn + l * 128 + lane * 2);
    const int stride = gridDim.x * 8;
    int row = blockIdx.x * 8 + w;
    float2 fa[8], fb[8], na[8], nb[8]; unsigned zz[8], nz[8];
#define CC_LOAD(ROW, A, B, Z) do { _Pragma("unroll") for (int h = 0; h < 8; ++h) { const size_t off_ = (size_t)(ROW) * 1024 + h * 128 + lane * 2; \
    A[h] = *reinterpret_cast<const float2*>(p.pbuf + off_); B[h] = *reinterpret_cast<const float2*>(p.pbuf + (size_t)TT * 1024 + off_); \
    Z[h] = *reinterpret_cast<const unsigned*>(p.proj + pidx((ROW), COL_CZ + h * 128) + lane * 2); } } while (0)
    if (row < TT) CC_LOAD(row, fa, fb, zz);
    for (; row < TT; row += stride) {
        if (row + stride < TT) CC_LOAD(row + stride, na, nb, nz);
        float s0[8], s1[8], ss[8];
#pragma unroll
        for (int h = 0; h < 8; ++h) { s0[h] = fa[h].x + fb[h].x; s1[h] = fa[h].y + fb[h].y; ss[h] = s0[h] * s0[h] + s1[h] * s1[h]; }
#pragma unroll
        for (int o = 32; o >= 1; o >>= 1) {
#pragma unroll
            for (int h = 0; h < 8; ++h) ss[h] += __shfl_xor(ss[h], o); }
#pragma unroll
        for (int h = 0; h < 8; ++h) { const float rstd = rsqrtf(ss[h] * (1.f / 128.f) + 1e-6f);
            const float z0 = __uint_as_float(zz[h] << 16), z1 = __uint_as_float(zz[h] & 0xffff0000u);
            *reinterpret_cast<unsigned*>(p.gin + (size_t)row * 3072 + 2048 + h * 128 + lane * 2) = cvtpk2(s0[h] * rstd * gn.x * silu_fast(z0), s1[h] * rstd * gn.y * silu_fast(z1)); }
#pragma unroll
        for (int h = 0; h < 8; ++h) { fa[h] = na[h]; fb[h] = nb[h]; zz[h] = nz[h]; }
    }
#undef CC_LOAD
}

__device__ __forceinline__ void ph_final(const Params& p) {
    const int tid = tidx(), w = tid >> 6, lane = tid & 63;
    for (int r = blockIdx.x * 8 + w; r < NB * SEQ; r += gridDim.x * 8) {
        const int b = r / SEQ, t = r - b * SEQ;
        const float* src = p.resid + ((size_t)b * TPB + CTXL + t) * DM;
        float4 v[8]; float ss = 0.f;
#pragma unroll
        for (int i = 0; i < 8; ++i) { v[i] = *reinterpret_cast<const float4*>(src + i * 256 + lane * 4); ss += v[i].x * v[i].x + v[i].y * v[i].y + v[i].z * v[i].z + v[i].w * v[i].w; }
        ss = wave_sum(ss);
        const float rstd = rsqrtf(ss * (1.f / DM) + 1e-6f);
#pragma unroll
        for (int i = 0; i < 8; ++i) { const int col = i * 256 + lane * 4; const float4 gv = *reinterpret_cast<const float4*>(p.final_g + col);
            float4 o; o.x = v[i].x * rstd * gv.x; o.y = v[i].y * rstd * gv.y; o.z = v[i].z * rstd * gv.z; o.w = v[i].w * rstd * gv.w;
            *reinterpret_cast<float4*>(p.out + (size_t)r * DM + col) = o; }
    }
}

__device__ __forceinline__ void ph_attn(const Params& p, int l, unsigned char* lds) {
    const int G = gridDim.x; const bool with_ctx = l < DEPTH - 1;
    for (int pass = 0; pass < 2; ++pass)
        for (int i = blockIdx.x; i < 512; i += G) {
            const int c = i & 255, rnd = i >> 8, xcd = c & 7, j = c >> 3, gi = xcd + 8 * rnd, b = gi >> 1, kvh = gi & 1, h = kvh * 4 + (j >> 3), qt = j & 7;
            if (pass == 0) att::attn_item<1>(p, l, b, h, qt, (char*)lds); else att::attn_item<0>(p, l, b, h, qt, (char*)lds);
        }
    if (with_ctx)
        for (int i = blockIdx.x; i < 128; i += G) { const int md = i & 1, bh = i >> 1, b = bh >> 3, h = bh & 7;
            if (md) att::attn_item<1>(p, l, b, h, 8, (char*)lds); else att::attn_item<0>(p, l, b, h, 8, (char*)lds); }
}

namespace xb {
#define XB_TMO      128
#define XB_XCNT(j)  (256  + 64 * (j))
#define XB_XSUB(j)  (1280 + 64 * (j))
#define XB_XGEN(j)  (2304 + 64 * (j))
#define XB_TOP      3328
#define XB_TOPGEN   3392
#define XCD_BAR_WORDS 3456
#define XB_SPIN_CAP (1u << 18)
#define LAS __attribute__((address_space(3)))

__device__ __forceinline__ unsigned xb_ld(unsigned* p)              { return __hip_atomic_load(p, __ATOMIC_RELAXED, __HIP_MEMORY_SCOPE_AGENT); }
__device__ __forceinline__ unsigned xb_add(unsigned* p, unsigned v) { return __hip_atomic_fetch_add(p, v, __ATOMIC_RELAXED, __HIP_MEMORY_SCOPE_AGENT); }
__device__ __forceinline__ unsigned xb_xcc_id() { return (unsigned)__builtin_amdgcn_s_getreg((3 << 11) | 20) & 0xFu; }
#define XB_SPIN(cond, bar) do { unsigned _sp = 0; while (cond) { __builtin_amdgcn_s_sleep(1); \
    if ((++_sp & 255u) == 0u) { if (xb_ld(&(bar)[XB_TMO])) break; if (_sp > XB_SPIN_CAP) { atomicAdd(&(bar)[XB_TMO], 1u); break; } } } } while (0)

struct XcdBarrier {
    unsigned* bar; unsigned x;
    volatile LAS unsigned* st;
};

__device__ __forceinline__ XcdBarrier xcd_barrier_post(unsigned* bar, volatile LAS unsigned* st) {
    XcdBarrier b; b.bar = bar; b.x = xb_xcc_id(); b.st = st;
    if (threadIdx.x == 0) (void)xb_add(&bar[XB_XCNT(b.x)], 1u);
    return b;
}
__device__ __forceinline__ void xcd_barrier_complete(unsigned* bar, unsigned x, unsigned& nloc, unsigned& nx) {
    const unsigned G = gridDim.x * gridDim.y * gridDim.z;
    unsigned sum, cnt, mine, sp = 0u;
    for (;;) {
        sum = 0u; cnt = 0u; mine = 0u;
#pragma unroll
        for (unsigned j = 0; j < 16; ++j) { const unsigned c = xb_ld(&bar[XB_XCNT(j)]); sum += c; cnt += (c > 0u) ? 1u : 0u; mine = (j == x) ? c : mine; }
        if (sum == G) break;
        __builtin_amdgcn_s_sleep(1);
        if ((++sp & 255u) == 0u) { if (xb_ld(&bar[XB_TMO])) break; if (sp > XB_SPIN_CAP) { atomicAdd(&bar[XB_TMO], 1u); break; } }
    }
    nloc = mine > 0u ? mine : 1u; nx = cnt > 0u ? cnt : 1u;
}

__device__ __forceinline__ void xcd_barrier(const XcdBarrier& b) {
    asm volatile("s_waitcnt vmcnt(0)" ::: "memory");
    __syncthreads();
    if (threadIdx.x == 0) {
        unsigned* bar = b.bar;
        __builtin_amdgcn_s_waitcnt(0);
        unsigned nloc = b.st[0], nx = b.st[1];
        if (nloc == 0u) { xcd_barrier_complete(bar, b.x, nloc, nx); b.st[0] = nloc; b.st[1] = nx; }
        const unsigned old = xb_add(&bar[XB_XSUB(b.x)], 1u);
        const unsigned gen = old / nloc;
        if (old + 1u == (gen + 1u) * nloc) {
            __builtin_amdgcn_fence(__ATOMIC_RELEASE, "agent");
            asm volatile("s_waitcnt vmcnt(0)" ::: "memory");
            const unsigned og = xb_add(&bar[XB_TOP], 1u);
            const unsigned tg = og / nx;
            if (og + 1u == (tg + 1u) * nx) xb_add(&bar[XB_TOPGEN], 1u);
            else XB_SPIN(xb_ld(&bar[XB_TOPGEN]) == tg, bar);
            __builtin_amdgcn_fence(__ATOMIC_ACQUIRE, "agent");
            xb_add(&bar[XB_XGEN(b.x)], 1u);
            asm volatile("s_waitcnt vmcnt(0)" ::: "memory");
        } else {
            XB_SPIN(xb_ld(&bar[XB_XGEN(b.x)]) == gen, bar);
            __builtin_amdgcn_fence(__ATOMIC_ACQUIRE, "agent");
            asm volatile("s_waitcnt vmcnt(0)" ::: "memory");
        }
    }
    __syncthreads();
}

}
__global__ void __launch_bounds__(512, 2) mega_fwd(Params p) {
    extern __shared__ __attribute__((aligned(16))) unsigned char lds[];
    cg::grid_group grid_ = cg::this_grid();
#define GSYNC_CG() do { __builtin_amdgcn_fence(__ATOMIC_RELEASE, "agent"); asm volatile("s_waitcnt vmcnt(0)" ::: "memory"); grid_.sync(); \
        __builtin_amdgcn_fence(__ATOMIC_ACQUIRE, "agent"); asm volatile("s_waitcnt vmcnt(0)" ::: "memory"); } while (0)
    volatile LAS unsigned* xst_ = (volatile LAS unsigned*)(lds + 131072);
    if (threadIdx.x == 0) { xst_[0] = 0u; xst_[1] = 0u; }
    __syncthreads();
    const xb::XcdBarrier xbar_ = xb::xcd_barrier_post(p.bar, xst_);
#define GSYNC() xb::xcd_barrier(xbar_)
    const int G = gridDim.x, c = blockIdx.x;
    grid_.sync();
    ph_prologue(p, lds);
    GSYNC();
    for (int l = 0; l < DEPTH; ++l) {
        const bool last = l == DEPTH - 1;
        ph_norm(p, l);
        GSYNC();
        { pg8::Gemm g; g.A = p.hbuf; g.Bt = p.WinT + (size_t)l * NP * DM; g.M = TT; g.N = NP; g.K = DM;
          Order S; if (last) { S.init(64, 64, 1, 1, G, c); S.tail = 128; } else S.init(72, 64, 1, 0, G, c);
          EpiProj E; E.O = p.proj;
          pg8::gemm_phase<EpiProj, Order, false>((PG8_LAS unsigned char*)lds, g, S, E, nullptr); }
        GSYNC();
        ph_kfix(p, l);
        for (int i = c; i < 256; i += G) hg::hgrn_item(p, l, i, lds);
        GSYNC();
        ph_attn(p, l, lds);
        ph_ccomb(p, l);
        GSYNC();
        { pg8::Gemm g; g.A = p.gin; g.Bt = p.WbT + (size_t)l * 3 * DM * 1024; g.M = TT; g.N = DM; g.K = 3072;
          Order S; S.init(last ? 64 : 72, 8, 1, last ? 1 : 0, G, c); EpiBranch E; E.proj = p.proj; E.merged = p.hbuf;
          pg8::gemm_phase<EpiBranch, Order, false>((PG8_LAS unsigned char*)lds, g, S, E, nullptr); }
        GSYNC();
        { pg8::Gemm g; g.A = p.hbuf; g.Bt = p.WoT + (size_t)l * DM * DM; g.M = TT; g.N = DM; g.K = DM;
          Order S; S.init(last ? 64 : 72, 8, 1, last ? 1 : 0, G, c); EpiOut E; E.x = p.x; E.ctx = p.ctx; E.resid = p.resid; E.modl = p.mod + (size_t)l * 9 * 6144; E.layer0 = l == 0;
          pg8::gemm_phase<EpiOut, Order, false>((PG8_LAS unsigned char*)lds, g, S, E, nullptr); }
        GSYNC();
    }
    ph_final(p);
}

extern "C" void kernel_launch(void* const* d_in, const int* in_sizes, int n_in, void* d_out, int out_size, void* d_ws, size_t ws_size, hipStream_t stream) {
    constexpr size_t SZ_WIN = (size_t)DEPTH * NP * DM * 2, SZ_WB = (size_t)DEPTH * 3 * DM * 1024 * 2, SZ_WO = (size_t)DEPTH * DM * DM * 2, SZ_RES = (size_t)TT * DM * 4, SZ_H = (size_t)TT * DM * 2,
                     SZ_PROJ = (size_t)TT * NP * 2, SZ_GIN = (size_t)3 * TT * 1024 * 2, SZ_PB = (size_t)TT * DM * 4, SZ_MOD = (size_t)DEPTH * 9 * 6144 * 4, SZ_LB = 8192 * 4, SZ_ROPE = (size_t)SEQ * 64 * 4;
    constexpr size_t O_WIN = 0, O_WB = O_WIN + SZ_WIN, O_WO = O_WB + SZ_WB, O_RES = O_WO + SZ_WO, O_H = O_RES + SZ_RES, O_PROJ = O_H + SZ_H, O_GIN = O_PROJ + SZ_PROJ, O_PB = O_GIN + SZ_GIN,
                     O_MOD = O_PB + SZ_PB, O_LB = O_MOD + ((SZ_MOD + 255) / 256) * 256, O_COS = O_LB + SZ_LB, O_SIN = O_COS + SZ_ROPE, O_BAR = O_SIN + SZ_ROPE, O_END = O_BAR + 16384;
    static int grid_blocks = 0;
    if (grid_blocks == 0) {
        if (n_in != 18 || out_size != NB * SEQ * DM || ws_size < O_END) { fprintf(stderr, "kernel_launch: unexpected shapes (n_in %d out %d ws %zu need %zu)\n", n_in, out_size, ws_size, (size_t)O_END); grid_blocks = -1; return; }
        int dev = 0, cus = 0, per_cu = 0;
        hipGetDevice(&dev);
        hipDeviceGetAttribute(&cus, hipDeviceAttributeMultiprocessorCount, dev);
        if (hipFuncSetAttribute((const void*)mega_fwd, hipFuncAttributeMaxDynamicSharedMemorySize, LDS_BYTES) != hipSuccess) { fprintf(stderr, "kernel_launch: hipFuncSetAttribute failed\n"); grid_blocks = -1; return; }
        if (hipOccupancyMaxActiveBlocksPerMultiprocessor(&per_cu, (const void*)mega_fwd, 512, LDS_BYTES) != hipSuccess || per_cu < 1) { fprintf(stderr, "kernel_launch: occupancy query failed (%d)\n", per_cu); (void)hipGetLastError(); per_cu = 1; }
        grid_blocks = cus * per_cu;
    }
    if (grid_blocks < 0) return;
    Params p{};
    p.x = (const float*)d_in[0]; p.c = (const float*)d_in[1]; p.ctx = (const float*)d_in[2]; p.c_ctx = (const float*)d_in[3]; p.ada_w = (const float*)d_in[4]; p.ada_b = (const float*)d_in[5];
    p.norm_g = (const float*)d_in[6]; p.w_in = (const float*)d_in[7]; p.a_sink = (const float*)d_in[8]; p.b_qn = (const float*)d_in[9]; p.b_kn = (const float*)d_in[10]; p.clb = (const float*)d_in[11];
    p.c_gn = (const float*)d_in[12]; p.w_ba = (const float*)d_in[13]; p.w_bb = (const float*)d_in[14]; p.w_bc = (const float*)d_in[15]; p.w_out = (const float*)d_in[16]; p.final_g = (const float*)d_in[17];
    p.out = (float*)d_out;
    char* ws = (char*)d_ws;
    p.WinT = (bf16_t*)(ws + O_WIN); p.WbT = (bf16_t*)(ws + O_WB); p.WoT = (bf16_t*)(ws + O_WO); p.resid = (float*)(ws + O_RES); p.hbuf = (bf16_t*)(ws + O_H); p.proj = (bf16_t*)(ws + O_PROJ);
    p.gin = (bf16_t*)(ws + O_GIN); p.pbuf = (float*)(ws + O_PB); p.mod = (float*)(ws + O_MOD); p.lbv = (float*)(ws + O_LB); p.cos_t = (float*)(ws + O_COS); p.sin_t = (float*)(ws + O_SIN); p.bar = (unsigned*)(ws + O_BAR);
    if (hipMemsetAsync(ws + O_BAR, 0, 16384, stream) != hipSuccess) { fprintf(stderr, "kernel_launch: memset of the barrier word failed\n"); return; }
    void* args[] = {&p};
    const hipError_t e = hipLaunchCooperativeKernel((const void*)mega_fwd, dim3(grid_blocks), dim3(512), args, LDS_BYTES, stream);
    if (e != hipSuccess) fprintf(stderr, "kernel_launch: cooperative launch failed: %s (grid %d)\n", hipGetErrorString(e), grid_blocks);
}
```

```cpp
#include <hip/hip_runtime.h>
#include <hip/hip_bf16.h>
#include <hip/hip_cooperative_groups.h>
#include <cstdio>
#include <cstdint>
namespace cg = cooperative_groups;

constexpr int NB = 8, SEQ = 2048, CTXL = 256, TPB = SEQ + CTXL, TT = NB * TPB, DM = 2048, NP = 16384, DEPTH = 4;
constexpr int COL_AQ = 0, COL_AK = 1024, COL_AV = 1280, COL_AZ = 1536, COL_BQ = 2560, COL_BK = 3584, COL_BV = 3840, COL_BZ = 4096;
constexpr int COL_CQ = 5120, COL_CZF = 6144, COL_CZB = 7168, COL_CI = 8192, COL_CZ = 9216, COL_GATE = 10240;
constexpr int LDS_BYTES = 131072 + 64;
typedef unsigned short bf16_t;

struct Params {
    const float* x; const float* c; const float* ctx; const float* c_ctx; const float* ada_w; const float* ada_b; const float* norm_g; const float* w_in;
    const float* a_sink; const float* b_qn; const float* b_kn; const float* clb; const float* c_gn; const float* w_ba; const float* w_bb; const float* w_bc;
    const float* w_out; const float* final_g;
    float* out;
    bf16_t* WinT; bf16_t* WbT; bf16_t* WoT; float* resid; bf16_t* hbuf; bf16_t* proj; bf16_t* gin; float* pbuf; float* mod; float* lbv; float* cos_t; float* sin_t; unsigned* bar;
};

__device__ __forceinline__ size_t pidx(int row, int col) { return ((size_t)(col >> 7) * TT + row) * 128 + (col & 127); }
__device__ __forceinline__ float bf2f(bf16_t u) { return __uint_as_float(((unsigned)u) << 16); }
typedef __bf16 bf16x2_ __attribute__((ext_vector_type(2)));
__device__ __forceinline__ unsigned cvtpk2(float lo, float hi) { bf16x2_ v; v[0] = (__bf16)lo; v[1] = (__bf16)hi; return __builtin_bit_cast(unsigned, v); }
__device__ __forceinline__ bf16_t f2bf(float f) { return (bf16_t)(cvtpk2(f, f) & 0xffffu); }
__device__ __forceinline__ float sigmoidf_(float z) { return 1.f / (1.f + __expf(-z)); }
__device__ __forceinline__ float siluf_(float z) { return z / (1.f + __expf(-z)); }
__device__ __forceinline__ float sigmoid_fast(float z) { return __builtin_amdgcn_rcpf(1.f + __expf(-z)); }
__device__ __forceinline__ float silu_fast(float z) { return z * __builtin_amdgcn_rcpf(1.f + __expf(-z)); }
__device__ __forceinline__ float wave_sum(float v) {
#pragma unroll
    for (int o = 32; o >= 1; o >>= 1) v += __shfl_xor(v, o);
    return v;
}

__device__ __forceinline__ int tidx() { int t = threadIdx.x; asm volatile("" : "+v"(t)); return t; }
namespace pg8 {
#define PG8_LAS __attribute__((address_space(3)))
typedef unsigned short bf16_t;
typedef short bf16x8 __attribute__((ext_vector_type(8)));
typedef float f32x4 __attribute__((ext_vector_type(4)));
typedef unsigned u32x4 __attribute__((ext_vector_type(4)));
constexpr int BM = 256, BK = 64, HALF = 128, HTB = HALF * BK * 2  , STAGE_BYTES = 8 * HTB, NXCD = 8, WGM = 8;

__host__ __device__ __forceinline__ int lds_byte(int r, int c) { const int st = (r >> 4) * 2 + (c >> 5), rr = r & 15, cc = c & 31, ob = rr * 64 + cc * 2; return st * 1024 + (ob ^ (((ob >> 9) & 1) << 5)); }
__host__ __device__ __forceinline__ void stage_rc(int b, int& R, int& C) { const int st = b / 1024, sb = b % 1024, swz = sb ^ (((sb >> 9) & 1) << 5); R = (st >> 1) * 16 + swz / 64; C = (st & 1) * 32 + (swz % 64) / 2; }
__host__ __device__ __forceinline__ int perm32(int rho) { const int n = rho >> 4, i = rho & 15; return 8 * (i >> 2) + 4 * n + (i & 3); }

struct Unit { int pm, pn; };
struct Gemm { const bf16_t* A; const bf16_t* Bt; int M, N, K; };

struct StaticOrder {
    int nM, nN, nwg, G, c;
    __host__ __device__ void init(int M, int N, int G_, int c_) { nM = M / BM; nN = N / BM; nwg = nM * nN; G = G_; c = c_; }
    __host__ __device__ bool next(int i, Unit& u) const {
        const long L = (long)i * G + c; if (L >= nwg) return false;
        int wgid = (int)L; { const int q = nwg / NXCD, r = nwg % NXCD, xcd = wgid % NXCD, off = wgid / NXCD; wgid = (xcd < r ? xcd * (q + 1) : r * (q + 1) + (xcd - r) * q) + off; }
        const int nig = WGM * nN, gid = wgid / nig, fm = gid * WGM, gsz = (nM - fm) < WGM ? (nM - fm) : WGM;
        u.pm = fm + ((wgid % nig) % gsz); u.pn = (wgid % nig) / gsz; return true;
    }
    __device__ __forceinline__ void a_ready(const Unit&) const {}
    __device__ __forceinline__ void done(const Unit&) const {}
};

template <class Epi, class Sched, bool STAMP = false>
__device__ __forceinline__ void gemm_phase(PG8_LAS unsigned char* lds, const Gemm g, const Sched& S, const Epi& E, unsigned long long* stamps) {
    const int tid = tidx(), wid = __builtin_amdgcn_readfirstlane(tid >> 6), lane = tid & 63, wr = wid >> 2, wc = wid & 3, fr = lane & 15, fq = lane >> 4;
    const int K = g.K, nt = K / BK;
    int ts_lo = 0, ts_hi = 0, nts = 0; const unsigned long long rt_entry = STAMP ? (unsigned long long)wall_clock64() : 0ull;
#define PG8_STAMP() do { if (STAMP && wid == 0 && nts < 64) { const unsigned long long _c = (unsigned long long)clock64(); \
        ts_lo = (lane == nts) ? (int)(unsigned)_c : ts_lo; ts_hi = (lane == nts) ? (int)(unsigned)(_c >> 32) : ts_hi; ++nts; } } while (0)
    PG8_STAMP();
    unsigned voffA[2], voffB[2];
#pragma unroll
    for (int i = 0; i < 2; ++i) { int R, C; stage_rc(tid * 16 + i * 8192, R, C); const int Rb = Epi::PERM ? ((R & ~31) + perm32(R & 31)) : R;
        voffA[i] = (unsigned)(R * K + C) * 2u; voffB[i] = (unsigned)(Rb * K + C) * 2u; }
    const size_t kstep = (size_t)(BK * 2);
    const size_t hstep = (size_t)HALF * K * 2;
    const size_t tstep = 2 * hstep;
    const unsigned ldsw = (unsigned)wid * 1024u;
    const int aoff = lds_byte(wr * 64 + fr, fq * 8), boff = lds_byte(wc * 32 + fr, fq * 8);
#define PG8_SA(b, h) (((b) * 2 + (h)) * HTB)
#define PG8_SB(b, h) ((4 + (b) * 2 + (h)) * HTB)
#define PG8_STAGE(bufoff, gbase, voff) do { _Pragma("unroll") for (int _i = 0; _i < 2; ++_i) \
        __builtin_amdgcn_global_load_lds((const unsigned*)((const char*)(gbase) + (voff)[_i]), (PG8_LAS unsigned*)(lds + (bufoff) + ldsw + _i * 8192), 16, 0, 0); } while (0)
#define PG8_LDA(dst, b, h) do { _Pragma("unroll") for (int m = 0; m < 4; ++m) _Pragma("unroll") for (int k = 0; k < 2; ++k) dst[m][k] = *(const PG8_LAS bf16x8*)(lds + PG8_SA(b, h) + aoff + m * 2048 + k * 1024); } while (0)
#define PG8_LDB(dst, b, h) do { _Pragma("unroll") for (int n = 0; n < 2; ++n) _Pragma("unroll") for (int k = 0; k < 2; ++k) dst[n][k] = *(const PG8_LAS bf16x8*)(lds + PG8_SB(b, h) + boff + n * 2048 + k * 1024); } while (0)
#define PG8_MMA(ai, bj, At, Bt) do { __builtin_amdgcn_s_setprio(1); _Pragma("unroll") for (int m = 0; m < 4; ++m) _Pragma("unroll") for (int n = 0; n < 2; ++n) _Pragma("unroll") for (int k = 0; k < 2; ++k) \
        acc[ai][bj][m][n] = __builtin_amdgcn_mfma_f32_16x16x32_bf16(Bt[n][k], At[m][k], acc[ai][bj][m][n], 0, 0, 0); __builtin_amdgcn_s_setprio(0); } while (0)
#define PG8_WAIT_V(n) asm volatile("s_waitcnt vmcnt(" #n ")" ::: "memory")
#define PG8_WAIT_L(n) asm volatile("s_waitcnt lgkmcnt(" #n ")" ::: "memory")
#define PG8_BAR __builtin_amdgcn_s_barrier()
#define PG8_SCHED __builtin_amdgcn_sched_barrier(0)
    Unit cur, nxt; int ui = 0;
    if (!S.next(0, cur)) return;
    f32x4 acc[2][2][4][2];
#pragma unroll
    for (int a = 0; a < 2; ++a)
#pragma unroll
        for (int b = 0; b < 2; ++b)
#pragma unroll
            for (int m = 0; m < 4; ++m)
#pragma unroll
                for (int n = 0; n < 2; ++n) acc[a][b][m][n] = (f32x4){0.f, 0.f, 0.f, 0.f};
    bf16x8 At[4][2], B0[2][2], B1[2][2];
    const char* cA = (const char*)g.A + (size_t)cur.pm * tstep; const char* cB = (const char*)g.Bt + (size_t)cur.pn * tstep;
    S.a_ready(cur);
    PG8_STAGE(PG8_SB(0, 0), cB, voffB); PG8_STAGE(PG8_SA(0, 0), cA, voffA); PG8_STAGE(PG8_SB(0, 1), cB + hstep, voffB); PG8_STAGE(PG8_SA(0, 1), cA + hstep, voffA);
    if (wr == 1) PG8_BAR;
    PG8_WAIT_V(4); PG8_BAR;
    PG8_STAGE(PG8_SB(1, 0), cB + kstep, voffB); PG8_STAGE(PG8_SA(1, 0), cA + kstep, voffA); PG8_STAGE(PG8_SB(1, 1), cB + hstep + kstep, voffB);
    PG8_WAIT_V(6); PG8_BAR;
    PG8_STAMP();
    for (;;) {
        const bool has_next = S.next(ui + 1, nxt);
        const char* nA = has_next ? (const char*)g.A + (size_t)nxt.pm * tstep : cA; const char* nB = has_next ? (const char*)g.Bt + (size_t)nxt.pn * tstep : cB;
        for (int t = 0; t < nt; t += 2) {
            const bool last = (t == nt - 2);
            const char* a1 = cA + (size_t)(t + 1) * kstep;
            const char* a2 = last ? nA : cA + (size_t)(t + 2) * kstep; const char* b2 = last ? nB : cB + (size_t)(t + 2) * kstep;
            const char* a3 = a2 + kstep; const char* b3 = b2 + kstep;
            if (last && has_next) S.a_ready(nxt);
            if constexpr (Epi::HAS_MID) { if (t == 16 || t == 32) E.mid(acc, cur, t, wr, wc, fr, fq); }
            PG8_LDB(B0, 0, 0); PG8_SCHED; PG8_LDA(At, 0, 0); PG8_STAGE(PG8_SA(1, 1), a1 + hstep, voffA);
            PG8_WAIT_L(8); PG8_BAR; PG8_WAIT_L(0); PG8_MMA(0, 0, At, B0); PG8_BAR; PG8_SCHED;
            PG8_LDB(B1, 0, 1); PG8_STAGE(PG8_SB(0, 0), b2, voffB);
            PG8_BAR; PG8_WAIT_L(0); PG8_MMA(0, 1, At, B1); PG8_BAR;
            PG8_LDA(At, 0, 1); PG8_STAGE(PG8_SA(0, 0), a2, voffA);
            PG8_BAR; PG8_WAIT_L(0); PG8_MMA(1, 0, At, B0); PG8_BAR; PG8_SCHED;
            PG8_STAGE(PG8_SB(0, 1), b2 + hstep, voffB);
            PG8_WAIT_V(6); PG8_BAR; PG8_MMA(1, 1, At, B1); PG8_BAR;
            PG8_LDB(B0, 1, 0); PG8_SCHED; PG8_LDA(At, 1, 0); PG8_STAGE(PG8_SA(0, 1), a2 + hstep, voffA);
            PG8_WAIT_L(8); PG8_BAR; PG8_WAIT_L(0); PG8_MMA(0, 0, At, B0); PG8_BAR; PG8_SCHED;
            PG8_LDB(B1, 1, 1); PG8_STAGE(PG8_SB(1, 0), b3, voffB);
            PG8_BAR; PG8_WAIT_L(0); PG8_MMA(0, 1, At, B1); PG8_BAR;
            PG8_LDA(At, 1, 1); PG8_STAGE(PG8_SA(1, 0), a3, voffA);
            PG8_BAR; PG8_WAIT_L(0); PG8_MMA(1, 0, At, B0); PG8_BAR; PG8_SCHED;
            PG8_STAGE(PG8_SB(1, 1), b3 + hstep, voffB);
            PG8_WAIT_V(6); PG8_BAR; PG8_MMA(1, 1, At, B1); PG8_BAR;
        }
        PG8_STAMP();
        if constexpr (!Epi::AFTER_DRAIN) { E(acc, cur, wr, wc, fr, fq); S.done(cur); }
        PG8_STAMP();
        if (!has_next) break;
#pragma unroll
        for (int a = 0; a < 2; ++a)
#pragma unroll
            for (int b = 0; b < 2; ++b)
#pragma unroll
                for (int m = 0; m < 4; ++m)
#pragma unroll
                    for (int n = 0; n < 2; ++n) acc[a][b][m][n] = (f32x4){0.f, 0.f, 0.f, 0.f};
        cur = nxt; cA = nA; cB = nB; ++ui;
    }
    PG8_WAIT_V(0);
    if (wr == 0) PG8_BAR;
    PG8_BAR;
    if constexpr (Epi::AFTER_DRAIN) { E.fused(acc, cur, wr, wc, fr, fq, lds, wid, lane); S.done(cur); }
    PG8_STAMP();
    if (STAMP && wid == 0) { stamps[lane] = lane < nts ? (((unsigned long long)(unsigned)ts_hi << 32) | (unsigned)ts_lo) : 0ull;
        if (lane == 62) stamps[62] = rt_entry; if (lane == 63) stamps[63] = (unsigned long long)wall_clock64(); }
#undef PG8_STAMP
#undef PG8_SA
#undef PG8_SB
#undef PG8_STAGE
#undef PG8_LDA
#undef PG8_LDB
#undef PG8_MMA
#undef PG8_WAIT_V
#undef PG8_WAIT_L
#undef PG8_BAR
#undef PG8_SCHED
}
}

namespace att {
using bf16 = __hip_bfloat16;
constexpr int D = 128, NW = 8, QBLK = 32, KVBLK = 64;
constexpr float SCALE = 0.088388347648318440f;
constexpr float THR = 8.f;
constexpr size_t SHM_V = KVBLK * D * 2, SHM_K = KVBLK * D * 2;
constexpr int LDK = 128;
using bf16x8 = __attribute__((ext_vector_type(8))) short;
using s16x4  = __attribute__((ext_vector_type(4))) short;
using f32x16 = __attribute__((ext_vector_type(16))) float;
using f32x8  = __attribute__((ext_vector_type(8))) float;
using u32x4  = __attribute__((ext_vector_type(4))) unsigned;
#define KSWZ(row, colB) ((row) * 256 + ((colB) ^ (((row) & 7) << 4)))
#define SBAR() __builtin_amdgcn_sched_barrier(0)
__device__ __forceinline__ int crow(int r, int hi) { return (r & 3) + 8 * (r >> 2) + 4 * hi; }
__device__ __forceinline__ unsigned cvtpk(float lo, float hi) {
  unsigned r; asm volatile("v_cvt_pk_bf16_f32 %0, %1, %2" : "=v"(r) : "v"(lo), "v"(hi)); return r;
}
template <typename TIn> struct Stage;
template <> struct Stage<bf16>  { using T = bf16x8;
  __device__ static __forceinline__ T ld8(const bf16* p) { return *reinterpret_cast<const bf16x8*>(p); }
  __device__ static __forceinline__ bf16x8 tobf(T x) { return x; } };
template <> struct Stage<float> { using T = f32x8;
  __device__ static __forceinline__ T ld8(const float* p) { return *reinterpret_cast<const f32x8*>(p); }
  __device__ static __forceinline__ bf16x8 tobf(T x) {
    u32x4 w = {cvtpk(x[0], x[1]), cvtpk(x[2], x[3]), cvtpk(x[4], x[5]), cvtpk(x[6], x[7])}; return *reinterpret_cast<bf16x8*>(&w); } };

__device__ __forceinline__ void partialSM(f32x16& p0, f32x16& p1, float& m_reg, float& mn, float& alpha) {
  constexpr float C = SCALE * 1.4426950408889634f;
  float pmax = p0[0]; for (int r = 1; r < 16; ++r) pmax = fmaxf(pmax, p0[r]); for (int r = 0; r < 16; ++r) pmax = fmaxf(pmax, p1[r]);
  { auto rr = __builtin_amdgcn_permlane32_swap(__float_as_uint(pmax), __float_as_uint(pmax), false, false);
    pmax = fmaxf(__uint_as_float(rr[0]), __uint_as_float(rr[1])); }
  if (__builtin_expect(__all(pmax - m_reg <= THR / SCALE), 1)) { mn = m_reg; alpha = 1.f; }
  else { mn = fmaxf(m_reg, pmax); alpha = __builtin_amdgcn_exp2f((m_reg - mn) * C); m_reg = mn; }
  float mnC = -mn * C;
  for (int r = 0; r < 16; ++r) p0[r] = fmaf(p0[r], C, mnC); for (int r = 0; r < 16; ++r) p1[r] = fmaf(p1[r], C, mnC);
  for (int r = 0; r < 16; ++r) p0[r] = __builtin_amdgcn_exp2f(p0[r]);
}
__device__ __forceinline__ void finishSM(f32x16& p0, f32x16& p1, float alpha, float& l_reg, bf16x8& pa0, bf16x8& pa1, bf16x8& pa2, bf16x8& pa3) {
  for (int r = 0; r < 16; ++r) p1[r] = __builtin_amdgcn_exp2f(p1[r]);
  float ps = 0; for (int r = 0; r < 16; ++r) ps += p0[r]; for (int r = 0; r < 16; ++r) ps += p1[r];
  { auto rr = __builtin_amdgcn_permlane32_swap(__float_as_uint(ps), __float_as_uint(ps), false, false);
    ps = __uint_as_float(rr[0]) + __uint_as_float(rr[1]); }
  l_reg = l_reg * alpha + ps;
#define PK4(P, BASE, OUT) do { unsigned a0 = cvtpk(P[BASE + 0], P[BASE + 1]), a1 = cvtpk(P[BASE + 2], P[BASE + 3]);   \
    unsigned b0 = cvtpk(P[BASE + 4], P[BASE + 5]), b1 = cvtpk(P[BASE + 6], P[BASE + 7]);                              \
    auto r0 = __builtin_amdgcn_permlane32_swap(a0, b0, false, false); auto r1 = __builtin_amdgcn_permlane32_swap(a1, b1, false, false); \
    u32x4 w = {r0[0], r1[0], r0[1], r1[1]}; OUT = *reinterpret_cast<bf16x8*>(&w); } while (0)
  PK4(p0, 0, pa0); PK4(p0, 8, pa1); PK4(p1, 0, pa2); PK4(p1, 8, pa3);
#undef PK4
}
__device__ __forceinline__ void qkt(f32x16& p0, f32x16& p1, const bf16* Ks, const bf16x8* qr, int r32, int hi) {
  p0 = f32x16{}; p1 = f32x16{};
  for (int d0 = 0; d0 < 8; ++d0) { int cb = (d0 * 16 + hi * 8) * 2;
    bf16x8 b0 = *reinterpret_cast<const bf16x8*>((const char*)Ks + KSWZ(r32, cb));
    bf16x8 b1 = *reinterpret_cast<const bf16x8*>((const char*)Ks + KSWZ(32 + r32, cb));
    p0 = __builtin_amdgcn_mfma_f32_32x32x16_bf16(b0, qr[d0], p0, 0, 0, 0);
    p1 = __builtin_amdgcn_mfma_f32_32x32x16_bf16(b1, qr[d0], p1, 0, 0, 0); }
}
__device__ __forceinline__ int v_st(int k, int c) { const int kk = (k & ~0xC) | ((k & 4) << 1) | ((k & 8) >> 1); return ((kk >> 3) * 4 + (c >> 5)) * 512 + ((kk & 7) * 32 + (c & 31)) * 2; }
__device__ __forceinline__ int v_rd_base(int lane) { return ((lane & 3) << 3) | (((lane >> 2) & 3) << 6) | (((lane >> 4) & 1) << 5) | (((lane >> 5) & 1) << 8); }
constexpr int v_rd_off(int d0, int ks, int half) { return d0 * 512 + ks * 4096 + half * 2048; }
template <int OFF> __device__ __forceinline__ s16x4 tr_read(int vb) {
  s16x4 r; asm volatile("ds_read_b64_tr_b16 %0, %1 offset:%2" : "=&v"(r) : "v"(vb), "i"(OFF) : "memory"); return r;
}
template <int D0> __device__ __forceinline__ void pv_one(f32x16& od, int vb, bf16x8 pa0, bf16x8 pa1, bf16x8 pa2, bf16x8 pa3) {
  const s16x4 l0 = tr_read<v_rd_off(D0, 0, 0)>(vb), h0 = tr_read<v_rd_off(D0, 0, 1)>(vb), l1 = tr_read<v_rd_off(D0, 1, 0)>(vb), h1 = tr_read<v_rd_off(D0, 1, 1)>(vb);
  const s16x4 l2 = tr_read<v_rd_off(D0, 2, 0)>(vb), h2 = tr_read<v_rd_off(D0, 2, 1)>(vb), l3 = tr_read<v_rd_off(D0, 3, 0)>(vb), h3 = tr_read<v_rd_off(D0, 3, 1)>(vb);
  asm volatile("s_waitcnt lgkmcnt(0)" ::: "memory"); SBAR();
#define PK(L, H) (bf16x8){L[0], L[1], L[2], L[3], H[0], H[1], H[2], H[3]}
  od = __builtin_amdgcn_mfma_f32_32x32x16_bf16(pa0, PK(l0, h0), od, 0, 0, 0);
  od = __builtin_amdgcn_mfma_f32_32x32x16_bf16(pa1, PK(l1, h1), od, 0, 0, 0);
  od = __builtin_amdgcn_mfma_f32_32x32x16_bf16(pa2, PK(l2, h2), od, 0, 0, 0);
  od = __builtin_amdgcn_mfma_f32_32x32x16_bf16(pa3, PK(l3, h3), od, 0, 0, 0);
#undef PK
}
__device__ __forceinline__ void pv_d0(f32x16* o, int vb, bf16x8 pa0, bf16x8 pa1, bf16x8 pa2, bf16x8 pa3) {
  pv_one<0>(o[0], vb, pa0, pa1, pa2, pa3); pv_one<1>(o[1], vb, pa0, pa1, pa2, pa3); pv_one<2>(o[2], vb, pa0, pa1, pa2, pa3); pv_one<3>(o[3], vb, pa0, pa1, pa2, pa3);
}

template <int MODE>
__device__ __forceinline__ void attn_item(const Params& p, int l, int b, int h, int qt, char* lds) {
  using St = Stage<bf16>;
  const int tid = tidx(), wid = __builtin_amdgcn_readfirstlane(tid >> 6), lane = tid & 63, r32 = lane & 31, hi = lane >> 5;
  const bool isLat = qt < 8;
  const int q0 = isLat ? qt * 256 : 0;
  const int qrow0 = b * TPB + (isLat ? CTXL + q0 : 0);
  const int kvh = h >> 2;
  constexpr int QCOL = MODE == 0 ? COL_AQ : COL_BQ, KCOL = MODE == 0 ? COL_AK : COL_BK, VCOL = MODE == 0 ? COL_AV : COL_BV, ZCOL = MODE == 0 ? COL_AZ : COL_BZ;
  int NT, wtok;
  if (!isLat) { NT = 4; wtok = CTXL; }
  else if (MODE == 1) { NT = 36; wtok = CTXL; }
  else { const int lo = q0 - 128 < 0 ? 0 : q0 - 128, hi_ = q0 + 384 > SEQ ? SEQ : q0 + 384; wtok = CTXL + lo; NT = 4 + (hi_ - lo) / 64; }
  const bf16* Kh = (const bf16*)(p.proj + pidx(b * TPB, KCOL + kvh * 128));
  const bf16* Vh = (const bf16*)(p.proj + pidx(b * TPB, VCOL + kvh * 128));
#define KT(j) ((j) < 4 ? (j) * 64 : wtok + ((j) - 4) * 64)
  bf16* V_lds = (bf16*)lds; bf16* K_lds = (bf16*)(lds + 2 * SHM_V);
  float* ws = (float*)(lds + 2 * SHM_V + 2 * SHM_K) + wid * 64; float* li_l = ws; float* al_l = ws + 32;
  float m_reg = -1e30f, l_reg = 0; f32x16 o[4] = {}; bf16x8 qr[8];
  {
    const bf16_t* Qw = p.proj + pidx(qrow0 + wid * QBLK + r32, QCOL + h * 128) + hi * 8;
    float xf[8][8];
#pragma unroll
    for (int d0 = 0; d0 < 8; ++d0) { const bf16x8 raw = *reinterpret_cast<const bf16x8*>(Qw + d0 * 16);
#pragma unroll
      for (int j = 0; j < 8; ++j) xf[d0][j] = bf2f((bf16_t)raw[j]); }
    if (MODE == 1) {
      float ss = 0.f;
#pragma unroll
      for (int d0 = 0; d0 < 8; ++d0)
#pragma unroll
        for (int j = 0; j < 8; ++j) ss += xf[d0][j] * xf[d0][j];
      ss += __shfl_xor(ss, 32);
      const float rstd = rsqrtf(ss * (1.f / 128.f) + 1e-6f);
      const float* qn = p.b_qn + l * 128 + hi * 8;
#pragma unroll
      for (int d0 = 0; d0 < 8; ++d0) { const float4 g0 = *(const float4*)(qn + d0 * 16), g1 = *(const float4*)(qn + d0 * 16 + 4);
        xf[d0][0] *= rstd * g0.x; xf[d0][1] *= rstd * g0.y; xf[d0][2] *= rstd * g0.z; xf[d0][3] *= rstd * g0.w;
        xf[d0][4] *= rstd * g1.x; xf[d0][5] *= rstd * g1.y; xf[d0][6] *= rstd * g1.z; xf[d0][7] *= rstd * g1.w; }
    }
    if (isLat) {
      const int pos = q0 + wid * QBLK + r32;
      const float* ct = p.cos_t + pos * 64 + hi * 8; const float* st = p.sin_t + pos * 64 + hi * 8;
#pragma unroll
      for (int d0 = 0; d0 < 4; ++d0) {
        const float4 c0 = *(const float4*)(ct + d0 * 16), c1 = *(const float4*)(ct + d0 * 16 + 4), s0 = *(const float4*)(st + d0 * 16), s1 = *(const float4*)(st + d0 * 16 + 4);
        const float cc[8] = {c0.x, c0.y, c0.z, c0.w, c1.x, c1.y, c1.z, c1.w}, sn[8] = {s0.x, s0.y, s0.z, s0.w, s1.x, s1.y, s1.z, s1.w};
#pragma unroll
        for (int j = 0; j < 8; ++j) { const float x1 = xf[d0][j], x2 = xf[d0 + 4][j]; xf[d0][j] = x1 * cc[j] - x2 * sn[j]; xf[d0 + 4][j] = x2 * cc[j] + x1 * sn[j]; }
      }
    }
#pragma unroll
    for (int d0 = 0; d0 < 8; ++d0) { u32x4 w = {cvtpk(xf[d0][0], xf[d0][1]), cvtpk(xf[d0][2], xf[d0][3]), cvtpk(xf[d0][4], xf[d0][5]), cvtpk(xf[d0][6], xf[d0][7])}; qr[d0] = *reinterpret_cast<bf16x8*>(&w); }
  }
  const int sr = tid >> 4, sc = (tid & 15) * 8, vst0 = v_st(sr, sc), vst1 = v_st(32 + sr, sc);
  const int vb0 = (int)(uintptr_t)V_lds + v_rd_base(lane);
  struct { typename St::T vs0, vs1, ks0, ks1; } sr_[2];
#define SLOAD(i, k0) do { const int k0_ = (k0); sr_[i].vs0 = St::ld8(&Vh[(long)(k0_ + sr) * LDK + sc]); sr_[i].vs1 = St::ld8(&Vh[(long)(k0_ + 32 + sr) * LDK + sc]); \
    sr_[i].ks0 = St::ld8(&Kh[(long)(k0_ + sr) * LDK + sc]); sr_[i].ks1 = St::ld8(&Kh[(long)(k0_ + 32 + sr) * LDK + sc]); } while (0)
#define SWRITE(b, i) do { *(bf16x8*)((char*)V_lds + (b) * SHM_V + vst0) = St::tobf(sr_[i].vs0);          \
    *(bf16x8*)((char*)V_lds + (b) * SHM_V + vst1) = St::tobf(sr_[i].vs1); int kc = sc * 2;               \
    *(bf16x8*)((char*)K_lds + (b) * SHM_K + KSWZ(sr, kc)) = St::tobf(sr_[i].ks0);                       \
    *(bf16x8*)((char*)K_lds + (b) * SHM_K + KSWZ(32 + sr, kc)) = St::tobf(sr_[i].ks1); } while (0)
#define SWAIT() asm volatile("s_waitcnt vmcnt(4)" ::: "memory")
#define RESC(a) do { if (__any((a) < 1.f)) { if (hi == 0) al_l[r32] = (a); asm volatile("s_waitcnt lgkmcnt(0)" ::: "memory"); \
    _Pragma("unroll") for (int d = 0; d < 4; ++d) _Pragma("unroll") for (int r = 0; r < 16; ++r) o[d][r] *= al_l[crow(r, hi)]; } } while (0)
#define MASK(P0, P1, j) do { if (MODE == 0 && isLat && (j) >= 4) { const int dq_ = (q0 + wid * QBLK + r32) - (KT(j) - CTXL); \
    _Pragma("unroll") for (int r = 0; r < 16; ++r) { const int e0_ = dq_ - crow(r, hi), e1_ = e0_ - 32; \
      if (e0_ > 128 || e0_ < -128) P0[r] = -1e30f; if (e1_ > 128 || e1_ < -128) P1[r] = -1e30f; } } } while (0)
  f32x16 pA0, pA1, pB0, pB1; float mnA, mnB, alA, alB; bf16x8 pa0, pa1, pa2, pa3;
  constexpr int SE = 0, SO = 1;
  SLOAD(SE, KT(0)); asm volatile("s_waitcnt vmcnt(0)" ::: "memory"); SWRITE(0, SE); __syncthreads();
  qkt(pA0, pA1, K_lds, qr, r32, hi); partialSM(pA0, pA1, m_reg, mnA, alA);
  SLOAD(SO, KT(1)); SLOAD(SE, KT(2));
  SWAIT(); SWRITE(1, SO); __syncthreads();
  for (int j = 1; j + 1 < NT; j += 2) {
    SBAR(); qkt(pB0, pB1, (bf16*)((char*)K_lds + SHM_K), qr, r32, hi); MASK(pB0, pB1, j);
    finishSM(pA0, pA1, alA, l_reg, pa0, pa1, pa2, pa3); SBAR();
    SLOAD(SO, KT(j + 2)); SBAR();
    pv_d0(o, vb0, pa0, pa1, pa2, pa3); partialSM(pB0, pB1, m_reg, mnB, alB);
    __syncthreads(); SWAIT(); SWRITE(0, SE);
    RESC(alB); __syncthreads();
    SBAR(); qkt(pA0, pA1, K_lds, qr, r32, hi); MASK(pA0, pA1, j + 1);
    finishSM(pB0, pB1, alB, l_reg, pa0, pa1, pa2, pa3); SBAR();
    { const int jn = j + 3 < NT ? j + 3 : NT - 1; SLOAD(SE, KT(jn)); } SBAR();
    pv_d0(o, vb0 + (int)SHM_V, pa0, pa1, pa2, pa3); partialSM(pA0, pA1, m_reg, mnA, alA);
    __syncthreads(); SWAIT(); SWRITE(1, SO);
    RESC(alA); __syncthreads();
  }
  SBAR(); qkt(pB0, pB1, (bf16*)((char*)K_lds + SHM_K), qr, r32, hi); MASK(pB0, pB1, NT - 1);
  finishSM(pA0, pA1, alA, l_reg, pa0, pa1, pa2, pa3); SBAR();
  pv_d0(o, vb0, pa0, pa1, pa2, pa3); partialSM(pB0, pB1, m_reg, mnB, alB);
  __syncthreads(); RESC(alB);
  finishSM(pB0, pB1, alB, l_reg, pa0, pa1, pa2, pa3); SBAR();
  pv_d0(o, vb0 + (int)SHM_V, pa0, pa1, pa2, pa3);
  if (MODE == 0) { constexpr float C = SCALE * 1.4426950408889634f; l_reg += __builtin_amdgcn_exp2f(p.a_sink[l * 8 + h] * 1.4426950408889634f - m_reg * C); }
  if (hi == 0) li_l[r32] = l_reg; asm volatile("s_waitcnt lgkmcnt(0)" ::: "memory");
  float rli[16];
#pragma unroll
  for (int r = 0; r < 16; ++r) rli[r] = __builtin_amdgcn_rcpf(li_l[crow(r, hi)]);
  __syncthreads();
  { float* Os = (float*)(lds + wid * 16384);
#pragma unroll
    for (int r = 0; r < 16; ++r) { const int orow = crow(r, hi);
#pragma unroll
      for (int d0 = 0; d0 < 4; ++d0) Os[orow * 128 + d0 * 32 + r32] = o[d0][r] * rli[r]; }
    const bf16_t* Zb = p.proj + pidx(qrow0 + wid * QBLK, ZCOL + h * 128);
    bf16_t* Ob = p.gin + (size_t)(qrow0 + wid * QBLK) * 3072 + MODE * 1024 + h * 128;
    bf16x8 zv[8];
#pragma unroll
    for (int i = 0; i < 8; ++i) zv[i] = *reinterpret_cast<const bf16x8*>(Zb + (i * 64 + lane) * 8);
#pragma unroll
    for (int i = 0; i < 8; ++i) { const int ch = i * 64 + lane, row = ch >> 4, c8 = (ch & 15) * 8;
      const f32x8 ov = *reinterpret_cast<const f32x8*>(Os + row * 128 + c8);
      float g[8];
#pragma unroll
      for (int j = 0; j < 8; ++j) g[j] = ov[j] * silu_fast(bf2f((bf16_t)zv[i][j]));
      u32x4 wv = {cvtpk2(g[0], g[1]), cvtpk2(g[2], g[3]), cvtpk2(g[4], g[5]), cvtpk2(g[6], g[7])};
      *reinterpret_cast<u32x4*>(Ob + (size_t)row * 3072 + c8) = wv; }
  }
  __syncthreads();
#undef KT
#undef SLOAD
#undef SWRITE
#undef SWAIT
#undef RESC
#undef MASK
}
}

namespace hg {
using att::bf16x8; using att::f32x16; using att::crow;
typedef unsigned u32x2 __attribute__((ext_vector_type(2)));
typedef unsigned u32x4_ __attribute__((ext_vector_type(4)));
constexpr int RS = 272, RS2 = 144;
constexpr int O_QD = 0, O_KD = O_QD + 64 * RS, O_QO = O_KD + 64 * RS, O_KO = O_QO + 32 * RS, O_QS = O_KO + 32 * RS, O_KST = O_QS + 64 * RS, O_VT = O_KST + 128 * RS2,
              O_P = O_VT + 64 * RS2, O_SBT = O_P + 64 * RS2, O_SEG = O_SBT + 64 * RS, O_ETOT = O_SEG + 4096, O_END = O_ETOT + 512;
static_assert(O_END <= LDS_BYTES, "hgrn LDS");
__device__ __forceinline__ bf16x8 ldf(const unsigned char* base, int row, int rs, int kk, int hi) { return *reinterpret_cast<const bf16x8*>(base + row * rs + (kk * 16 + hi * 8) * 2); }

__device__ __forceinline__ void hgrn_item(const Params& p, int l, int item, unsigned char* lds) {
  const int tid = tidx(), w = __builtin_amdgcn_readfirstlane(tid >> 6), lane = tid & 63, r32 = lane & 31, hi = lane >> 5;
  const int vh = item & 1, dir = (item >> 1) & 1, h = (item >> 2) & 7, b = item >> 5;
  const bf16_t* projb = p.proj + (size_t)b * TPB * 128;
  const size_t qcol = pidx(0, COL_CQ + h * 128) + 2 * lane, zcol = pidx(0, (dir ? COL_CZB : COL_CZF) + h * 128) + 2 * lane, vcol = pidx(0, COL_CI + h * 128) + vh * 64;
  const float2 lbk = *reinterpret_cast<const float2*>(p.lbv + (l * 2 + dir) * 1024 + h * 128 + 2 * lane);
  const float oml0 = 1.f - lbk.x, oml1 = 1.f - lbk.y;
  const int vs = tid >> 3, vc = (tid & 7) * 8;
  unsigned char* Qd = lds + O_QD; unsigned char* Kd = lds + O_KD; unsigned char* Qo = lds + O_QO; unsigned char* Ko = lds + O_KO; unsigned char* Qs = lds + O_QS;
  unsigned char* KsT = lds + O_KST; unsigned char* VT = lds + O_VT; unsigned char* P = lds + O_P; unsigned char* SbT = lds + O_SBT;
  float* segtot = (float*)(lds + O_SEG); float* etot = (float*)(lds + O_ETOT);
  for (int i = tid; i < 64 * RS / 4; i += 512) ((unsigned*)SbT)[i] = 0u;
  f32x16 Sacc = {};
  const int sgn = dir ? -1 : 1;
  unsigned zzA[8], qqA[8], zzB[8], qqB[8]; bf16x8 vrA, vrB;
  float* od = p.pbuf + (size_t)dir * TT * 1024 + (size_t)b * TPB * 1024 + h * 128 + vh * 64;
  constexpr float L2E = 1.4426950408889634f, QS = 0.088388347648318440f;
#define CHBASE(c) (dir ? ((c) < 4 ? 255 - 64 * (c) : 2303 - 64 * ((c) - 4)) : 64 * (c))
#define LOADCH(c, ZZ, QQ, VR) do { const int pb_ = CHBASE(c); \
    _Pragma("unroll") for (int i = 0; i < 8; ++i) { const bf16_t* rp_ = projb + (size_t)(pb_ + sgn * (8 * w + i)) * 128; ZZ[i] = *reinterpret_cast<const unsigned*>(rp_ + zcol); QQ[i] = *reinterpret_cast<const unsigned*>(rp_ + qcol); } \
    VR = *reinterpret_cast<const bf16x8*>(projb + (size_t)(pb_ + sgn * vs) * 128 + vcol + vc); } while (0)
  LOADCH(0, zzA, qqA, vrA); LOADCH(1, zzB, qqB, vrB);
  float cu0[8], cu1[8], kk0[8], kk1[8];
  auto a1 = [&](const unsigned (&zz)[8]) __attribute__((always_inline)) {
    float run0 = 0.f, run1 = 0.f;
#pragma unroll
    for (int i = 0; i < 8; ++i) {
      const float z0 = fmaxf(__uint_as_float(zz[i] << 16), -60.f), z1 = fmaxf(__uint_as_float(zz[i] & 0xffff0000u), -60.f);
      const float e0 = __builtin_amdgcn_exp2f(-z0 * L2E), e1 = __builtin_amdgcn_exp2f(-z1 * L2E);
      const float s0 = __builtin_amdgcn_rcpf(1.f + e0), s1 = __builtin_amdgcn_rcpf(1.f + e1);
      run0 += __builtin_amdgcn_logf(lbk.x + oml0 * s0); run1 += __builtin_amdgcn_logf(lbk.y + oml1 * s1);
      cu0[i] = run0; cu1[i] = run1; kk0[i] = oml0 * e0 * s0; kk1[i] = oml1 * e1 * s1; }
    *reinterpret_cast<float2*>(segtot + w * 128 + 2 * lane) = make_float2(run0, run1);
  };
  a1(zzA);
  __syncthreads();
  auto body = [&](const int c, unsigned (&zz)[8], unsigned (&qq)[8], bf16x8& vr, const unsigned (&nzz)[8]) __attribute__((always_inline)) {
    const int pbase = CHBASE(c);
    { float2 sg[8];
#pragma unroll
      for (int j = 0; j < 8; ++j) sg[j] = *reinterpret_cast<const float2*>(segtot + j * 128 + 2 * lane);
      float pre0 = 0.f, pre1 = 0.f;
#pragma unroll
      for (int j = 0; j < 8; ++j) { if (j < w) { pre0 += sg[j].x; pre1 += sg[j].y; } }
      const float a15 = sg[0].x + sg[1].x, a31 = a15 + sg[2].x + sg[3].x, a47 = a31 + sg[4].x + sg[5].x, atot = a47 + sg[6].x + sg[7].x;
      const float b15 = sg[0].y + sg[1].y, b31 = b15 + sg[2].y + sg[3].y, b47 = b31 + sg[4].y + sg[5].y, btot = b47 + sg[6].y + sg[7].y;
      const bool lo = w < 4;
      const float ra = lo ? a15 : a47, rb = lo ? b15 : b47;
      const float cOa = __builtin_amdgcn_exp2f(lo ? a31 - ra : ra - a31), cOb = __builtin_amdgcn_exp2f(lo ? b31 - rb : rb - b31);
      const float cSa = __builtin_amdgcn_exp2f(ra), cSb = __builtin_amdgcn_exp2f(rb);
      const float cTa = __builtin_amdgcn_exp2f(atot - ra), cTb = __builtin_amdgcn_exp2f(btot - rb);
      if (w == 0) *reinterpret_cast<float2*>(etot + 2 * lane) = make_float2(__builtin_amdgcn_exp2f(atot), __builtin_amdgcn_exp2f(btot));
      float ks0[8], ks1[8];
#pragma unroll
      for (int i = 0; i < 8; ++i) { const int t = 8 * w + i;
        const float d0 = cu0[i] + pre0 - ra, d1 = cu1[i] + pre1 - rb;
        const float ea = __builtin_amdgcn_exp2f(fminf(d0, 115.f)), eb = __builtin_amdgcn_exp2f(fminf(d1, 115.f));
        const float ia = __builtin_amdgcn_exp2f(fminf(-d0, 115.f)), ib = __builtin_amdgcn_exp2f(fminf(-d1, 115.f));
        const float q0 = __uint_as_float(qq[i] << 16) * QS, q1 = __uint_as_float(qq[i] & 0xffff0000u) * QS;
        const float qa = q0 * ea, qb = q1 * eb, ka = kk0[i] * ia, kb = kk1[i] * ib;
        *reinterpret_cast<unsigned*>(Qd + t * RS + lane * 4) = cvtpk2(qa, qb);
        *reinterpret_cast<unsigned*>(Kd + t * RS + lane * 4) = cvtpk2(ka, kb);
        if (lo) *reinterpret_cast<unsigned*>(Ko + t * RS + lane * 4) = cvtpk2(ka * cOa, kb * cOb);
        else    *reinterpret_cast<unsigned*>(Qo + (t - 32) * RS + lane * 4) = cvtpk2(qa * cOa, qb * cOb);
        *reinterpret_cast<unsigned*>(Qs + t * RS + lane * 4) = cvtpk2(q0 * (ea * cSa), q1 * (eb * cSb));
        ks0[i] = kk0[i] * (ia * cTa); ks1[i] = kk1[i] * (ib * cTb); }
      const u32x4_ w0 = {cvtpk2(ks0[0], ks0[1]), cvtpk2(ks0[2], ks0[3]), cvtpk2(ks0[4], ks0[5]), cvtpk2(ks0[6], ks0[7])};
      const u32x4_ w1 = {cvtpk2(ks1[0], ks1[1]), cvtpk2(ks1[2], ks1[3]), cvtpk2(ks1[4], ks1[5]), cvtpk2(ks1[6], ks1[7])};
      *reinterpret_cast<u32x4_*>(KsT + (2 * lane) * RS2 + w * 16) = w0; *reinterpret_cast<u32x4_*>(KsT + (2 * lane + 1) * RS2 + w * 16) = w1; }
#pragma unroll
    for (int j = 0; j < 8; ++j) ((bf16_t*)VT)[(vc + j) * (RS2 / 2) + vs] = (bf16_t)vr[j];
    if (c + 2 < 36) LOADCH(c + 2, zz, qq, vr);
    __syncthreads();
    f32x16 oacc = {};
    const int tb = (w - 4) >> 1, vb = (w - 4) & 1;
    if (w < 3) {
      const unsigned char* Asrc = w == 2 ? Ko : Kd + (32 * w) * RS; const unsigned char* Bsrc = w == 2 ? Qo : Qd + (32 * w) * RS;
      f32x16 acc = {};
#pragma unroll
      for (int q = 0; q < 8; ++q) acc = __builtin_amdgcn_mfma_f32_32x32x16_bf16(ldf(Asrc, r32, RS, q, hi), ldf(Bsrc, r32, RS, q, hi), acc, 0, 0, 0);
      const int trow = (w == 0 ? 0 : 32) + r32, scol0 = (w == 1 ? 32 : 0);
#pragma unroll
      for (int g = 0; g < 4; ++g) { const int s0 = 8 * g + 4 * hi; float v0 = acc[4 * g], v1 = acc[4 * g + 1], v2 = acc[4 * g + 2], v3 = acc[4 * g + 3];
        if (w < 2) { v0 = (s0 <= r32) ? v0 : 0.f; v1 = (s0 + 1 <= r32) ? v1 : 0.f; v2 = (s0 + 2 <= r32) ? v2 : 0.f; v3 = (s0 + 3 <= r32) ? v3 : 0.f; }
        u32x2 pk = {cvtpk2(v0, v1), cvtpk2(v2, v3)}; *reinterpret_cast<u32x2*>(P + trow * RS2 + (scol0 + s0) * 2) = pk; }
    } else if (w >= 4) {
#pragma unroll
      for (int q = 0; q < 8; ++q) oacc = __builtin_amdgcn_mfma_f32_32x32x16_bf16(ldf(Qs, 32 * tb + r32, RS, q, hi), ldf(SbT, 32 * vb + r32, RS, q, hi), oacc, 0, 0, 0);
    }
    __syncthreads();
    if (w >= 4) {
      const int nks = tb == 0 ? 2 : 4;
      for (int q = 0; q < nks; ++q) oacc = __builtin_amdgcn_mfma_f32_32x32x16_bf16(ldf(P, 32 * tb + r32, RS2, q, hi), ldf(VT, 32 * vb + r32, RS2, q, hi), oacc, 0, 0, 0);
#pragma unroll
      for (int r = 0; r < 16; ++r) { const int t = 32 * tb + crow(r, hi); od[(size_t)(pbase + sgn * t) * 1024 + 32 * vb + r32] = oacc[r]; }
    }
    { const int kb = w >> 1, vb2 = w & 1;
#pragma unroll
      for (int r = 0; r < 16; ++r) Sacc[r] *= etot[32 * kb + crow(r, hi)];
#pragma unroll
      for (int q = 0; q < 4; ++q) Sacc = __builtin_amdgcn_mfma_f32_32x32x16_bf16(ldf(KsT, 32 * kb + r32, RS2, q, hi), ldf(VT, 32 * vb2 + r32, RS2, q, hi), Sacc, 0, 0, 0);
#pragma unroll
      for (int g = 0; g < 4; ++g) { u32x2 pk = {cvtpk2(Sacc[4 * g], Sacc[4 * g + 1]), cvtpk2(Sacc[4 * g + 2], Sacc[4 * g + 3])};
        *reinterpret_cast<u32x2*>(SbT + (32 * vb2 + r32) * RS + (32 * kb + 8 * g + 4 * hi) * 2) = pk; } }
    if (c + 1 < 36) a1(nzz);
    __syncthreads();
  };
  for (int c = 0; c < 36; c += 2) { body(c, zzA, qqA, vrA, zzB); body(c + 1, zzB, qqB, vrB, zzA); }
#undef CHBASE
#undef LOADCH
}
}

struct Order {
    int nM, nN, nwg, G, c, rep, skipctx, tail;
    __device__ void init(int nM_, int nN_, int rep_, int skipctx_, int G_, int c_) { nM = nM_; nN = nN_; nwg = nM * nN; G = G_; c = c_; rep = rep_; skipctx = skipctx_; tail = 0; }
    __device__ bool next(int i, pg8::Unit& u) const {
        const int tr = rep == 3 ? i / 3 : i, xb = rep == 3 ? i - 3 * tr : 0;
        const long L = (long)tr * G + c;
        if (L >= nwg) { const int r = (int)(L - nwg); if (r >= tail) return false;
            const int k = r & 15; u.pm = (r >> 4) * 9; u.pn = k < 2 ? 4 + k : (k < 4 ? 12 + k : 20 + k); return true; }
        int wgid = (int)L; { const int q = nwg / pg8::NXCD, r = nwg % pg8::NXCD, xcd = wgid % pg8::NXCD, off = wgid / pg8::NXCD; wgid = (xcd < r ? xcd * (q + 1) : r * (q + 1) + (xcd - r) * q) + off; }
        const int nig = pg8::WGM * nN, gid = wgid / nig, fm = gid * pg8::WGM, gsz = (nM - fm) < pg8::WGM ? (nM - fm) : pg8::WGM;
        int pm = fm + ((wgid % nig) % gsz); const int pn = (wgid % nig) / gsz;
        if (skipctx) pm = pm + pm / 8 + 1;
        u.pm = pm + 72 * xb; u.pn = pn + 8 * xb; return true;
    }
    __device__ __forceinline__ void a_ready(const pg8::Unit&) const {}
    __device__ __forceinline__ void done(const pg8::Unit&) const {}
};
typedef float f32x4_ __attribute__((ext_vector_type(4)));
typedef unsigned u32x4_ __attribute__((ext_vector_type(4)));
typedef short s16x8_ __attribute__((ext_vector_type(8)));
struct EpiProj {
    static constexpr bool PERM = true, AFTER_DRAIN = false, HAS_MID = false;
    bf16_t* O;
    __device__ __forceinline__ void operator()(const pg8::f32x4 (&acc)[2][2][4][2], const pg8::Unit& u, int wr, int wc, int fr, int fq) const {
        int row0 = u.pm * 256 + wr * 64 + fr, col0 = u.pn * 256 + wc * 32 + 8 * fq;
        asm volatile("" : "+v"(row0), "+v"(col0));
        const bool gate = u.pn >= COL_GATE / 256;
#pragma unroll
        for (int ai = 0; ai < 2; ++ai)
#pragma unroll
            for (int m = 0; m < 4; ++m) { bf16_t* rowp = O + pidx(row0 + ai * 128 + m * 16, col0);
#pragma unroll
                for (int bj = 0; bj < 2; ++bj) { pg8::f32x4 v0 = acc[ai][bj][m][0], v1 = acc[ai][bj][m][1];
                    if (gate) {
#pragma unroll
                        for (int j = 0; j < 4; ++j) { v0[j] = 1.f + __expf(fminf(-v0[j], 80.f)); v1[j] = 1.f + __expf(fminf(-v1[j], 80.f)); } }
                    const u32x4_ w = {cvtpk2(v0[0], v0[1]), cvtpk2(v0[2], v0[3]), cvtpk2(v1[0], v1[1]), cvtpk2(v1[2], v1[3])};
                    *reinterpret_cast<u32x4_*>(rowp + (size_t)bj * TT * 128) = w; } }
    }
};
struct EpiBranch {
    static constexpr bool PERM = true, AFTER_DRAIN = false, HAS_MID = true;
    const bf16_t* proj; bf16_t* merged;
    __device__ __forceinline__ void mid(pg8::f32x4 (&acc)[2][2][4][2], const pg8::Unit& u, int t, int wr, int wc, int fr, int fq) const {
        const int xb = (t >> 4) - 1;
        int row0 = u.pm * 256 + wr * 64 + fr, col0 = u.pn * 256 + wc * 32 + 8 * fq;
        asm volatile("" : "+v"(row0), "+v"(col0));
#pragma unroll
        for (int ai = 0; ai < 2; ++ai)
#pragma unroll
            for (int bj = 0; bj < 2; ++bj) { const int col = col0 + bj * 128;
                s16x8_ ga[4], gb[4];
#pragma unroll
                for (int m = 0; m < 4; ++m) { const int row = row0 + ai * 128 + m * 16;
                    ga[m] = *reinterpret_cast<const s16x8_*>(proj + pidx(row, COL_GATE + xb * 2048 + col));
                    gb[m] = *reinterpret_cast<const s16x8_*>(proj + pidx(row, COL_GATE + (xb + 1) * 2048 + col)); }
#pragma unroll
                for (int m = 0; m < 4; ++m)
#pragma unroll
                    for (int j = 0; j < 4; ++j) {
                        acc[ai][bj][m][0][j] *= bf2f((bf16_t)gb[m][j]) * __builtin_amdgcn_rcpf(bf2f((bf16_t)ga[m][j]));
                        acc[ai][bj][m][1][j] *= bf2f((bf16_t)gb[m][4 + j]) * __builtin_amdgcn_rcpf(bf2f((bf16_t)ga[m][4 + j])); } }
    }
    __device__ __forceinline__ void operator()(const pg8::f32x4 (&acc)[2][2][4][2], const pg8::Unit& u, int wr, int wc, int fr, int fq) const {
        int row0 = u.pm * 256 + wr * 64 + fr, col0 = u.pn * 256 + wc * 32 + 8 * fq;
        asm volatile("" : "+v"(row0), "+v"(col0));
#pragma unroll
        for (int ai = 0; ai < 2; ++ai) {
            s16x8_ gzs[4][2];
#pragma unroll
            for (int m = 0; m < 4; ++m)
#pragma unroll
                for (int bj = 0; bj < 2; ++bj) gzs[m][bj] = *reinterpret_cast<const s16x8_*>(proj + pidx(row0 + ai * 128 + m * 16, COL_GATE + 2 * 2048 + col0 + bj * 128));
#pragma unroll
            for (int m = 0; m < 4; ++m) { const int row = row0 + ai * 128 + m * 16;
#pragma unroll
                for (int bj = 0; bj < 2; ++bj) { const int col = col0 + bj * 128;
                    const s16x8_ gz = gzs[m][bj];
                    const pg8::f32x4 v0 = acc[ai][bj][m][0], v1 = acc[ai][bj][m][1];
                    f32x4_ r0, r1;
#pragma unroll
                    for (int j = 0; j < 4; ++j) { r0[j] = v0[j] * __builtin_amdgcn_rcpf(bf2f((bf16_t)gz[j])); r1[j] = v1[j] * __builtin_amdgcn_rcpf(bf2f((bf16_t)gz[4 + j])); }
                    const u32x4_ w = {cvtpk2(r0[0], r0[1]), cvtpk2(r0[2], r0[3]), cvtpk2(r1[0], r1[1]), cvtpk2(r1[2], r1[3])};
                    *reinterpret_cast<u32x4_*>(merged + (size_t)row * DM + col) = w; } } }
    }
};
struct EpiOut {
    static constexpr bool PERM = true, AFTER_DRAIN = false, HAS_MID = false;
    const float* x; const float* ctx; float* resid; const float* modl; int layer0;
    __device__ __forceinline__ void operator()(const pg8::f32x4 (&acc)[2][2][4][2], const pg8::Unit& u, int wr, int wc, int fr, int fq) const {
        const int pm = u.pm, b = pm / 9, pc = pm - 9 * b;
        int rin0 = wr * 64 + fr, col0 = u.pn * 256 + wc * 32 + 8 * fq;
        asm volatile("" : "+v"(rin0), "+v"(col0));
        const float* gt = modl + (size_t)(pc == 0 ? 8 : b) * 6144 + 4096;
        const float* srcp = layer0 ? (pc == 0 ? ctx + (size_t)b * CTXL * DM : x + ((size_t)b * SEQ + (pc - 1) * 256) * DM) : resid + (size_t)pm * 256 * DM;
        float* dstp = resid + (size_t)pm * 256 * DM;
#pragma unroll
        for (int bj = 0; bj < 2; ++bj) { const int col = col0 + bj * 128;
            const f32x4_ g0 = *reinterpret_cast<const f32x4_*>(gt + col), g1 = *reinterpret_cast<const f32x4_*>(gt + col + 4);
#pragma unroll
            for (int ai = 0; ai < 2; ++ai) {
                f32x4_ s0[4], s1[4];
#pragma unroll
                for (int m = 0; m < 4; ++m) { const size_t ro = (size_t)(rin0 + ai * 128 + m * 16) * DM + col;
                    s0[m] = *reinterpret_cast<const f32x4_*>(srcp + ro); s1[m] = *reinterpret_cast<const f32x4_*>(srcp + ro + 4); }
#pragma unroll
                for (int m = 0; m < 4; ++m) { const size_t ro = (size_t)(rin0 + ai * 128 + m * 16) * DM + col;
                    const pg8::f32x4 v0 = acc[ai][bj][m][0], v1 = acc[ai][bj][m][1];
                    f32x4_ r0, r1;
#pragma unroll
                    for (int j = 0; j < 4; ++j) { r0[j] = s0[m][j] + g0[j] * v0[j]; r1[j] = s1[m][j] + g1[j] * v1[j]; }
                    *reinterpret_cast<f32x4_*>(dstp + ro) = r0; *reinterpret_cast<f32x4_*>(dstp + ro + 4) = r1; } } }
    }
};

__device__ __forceinline__ void ph_prologue(const Params& p, unsigned char* lds) {
    const int tid = tidx(), G = gridDim.x, wg = blockIdx.x, w = tid >> 6, lane = tid & 63;
    if (wg < 192) {
        float* sc = (float*)lds; float* red = sc + 9 * 2048;
        for (int i = tid; i < 9 * 2048; i += 512) { const int r = i >> 11, k = i & 2047; const float v = r < 8 ? p.c[r * 2048 + k] : p.c_ctx[k]; sc[i] = siluf_(v); }
        __syncthreads();
        for (int item = wg; item < 192; item += G) {
            const int l = item / 48, n0 = (item - l * 48) * 128;
            const float* wp = p.ada_w + ((size_t)l * 2048 + w * 256) * 6144 + n0 + lane * 2;
            const float* sp = sc + w * 256;
            float a0[9], a1[9];
#pragma unroll
            for (int r = 0; r < 9; ++r) { a0[r] = 0.f; a1[r] = 0.f; }
#pragma unroll 8
            for (int k = 0; k < 256; ++k) { const float2 wv = *reinterpret_cast<const float2*>(wp + (size_t)k * 6144);
#pragma unroll
                for (int r = 0; r < 9; ++r) { const float s = sp[r * 2048 + k]; a0[r] += s * wv.x; a1[r] += s * wv.y; } }
#pragma unroll
            for (int r = 0; r < 9; ++r) { red[(w * 9 + r) * 128 + lane * 2] = a0[r]; red[(w * 9 + r) * 128 + lane * 2 + 1] = a1[r]; }
            __syncthreads();
            for (int i = tid; i < 9 * 128; i += 512) { const int r = i >> 7, n = i & 127; float s = 0.f;
#pragma unroll
                for (int w2 = 0; w2 < 8; ++w2) s += red[(w2 * 9 + r) * 128 + n];
                p.mod[((size_t)l * 9 + r) * 6144 + n0 + n] = s + p.ada_b[l * 6144 + n0 + n]; }
            __syncthreads();
        }
    }
    {
        __syncthreads();
        float* tile = (float*)lds;
        constexpr int T_IN = 4 * 32 * 256, T_BR = 12 * 16 * 32, T_OUT = 4 * 32 * 32, T_ALL = T_IN + T_BR + T_OUT;
        const int rr0 = tid >> 4, c4 = (tid & 15) * 4, kg = tid & 7, nn = tid >> 3;
        auto decode = [&](int t, const float*& srcp, bf16_t*& dstp, int& ldd) __attribute__((always_inline)) {
            const float* src; bf16_t* dst; int K, N, kt, nt;
            if (t < T_IN) { const int l = t / 8192, r = t - l * 8192; K = 2048; N = 16384; kt = r / 256; nt = r - kt * 256; src = p.w_in + (size_t)l * K * N; dst = p.WinT + (size_t)l * K * N; ldd = K; }
            else if (t < T_IN + T_BR) { const int t2 = t - T_IN, lx = t2 / 512, r = t2 - lx * 512, l = lx / 3, xb = lx - 3 * l; K = 1024; N = 2048; kt = r / 32; nt = r - kt * 32;
                src = (xb == 0 ? p.w_ba : (xb == 1 ? p.w_bb : p.w_bc)) + (size_t)l * K * N; dst = p.WbT + (size_t)l * 3 * K * N + xb * 1024; ldd = 3072; }
            else { const int t2 = t - T_IN - T_BR, l = t2 / 1024, r = t2 - l * 1024; K = 2048; N = 2048; kt = r / 32; nt = r - kt * 32; src = p.w_out + (size_t)l * K * N; dst = p.WoT + (size_t)l * K * N; ldd = K; }
            srcp = src + (size_t)(kt * 64 + rr0) * N + nt * 64 + c4;
            dstp = dst + (size_t)(nt * 64 + nn) * ldd + kt * 64 + kg * 8;
            return N;
        };
        const float* srcp; bf16_t* dstp; int ldd; int N = 0; float4 va = make_float4(0.f, 0.f, 0.f, 0.f), vb = va;
        int t = wg; if (t < T_ALL) { N = decode(t, srcp, dstp, ldd); va = *reinterpret_cast<const float4*>(srcp); vb = *reinterpret_cast<const float4*>(srcp + (size_t)32 * N); }
        for (int it = 0; t < T_ALL; t += G, ++it) {
            float* tb = tile + (it & 1) * (64 * 65);
            tb[rr0 * 65 + c4] = va.x; tb[rr0 * 65 + c4 + 1] = va.y; tb[rr0 * 65 + c4 + 2] = va.z; tb[rr0 * 65 + c4 + 3] = va.w;
            tb[(rr0 + 32) * 65 + c4] = vb.x; tb[(rr0 + 32) * 65 + c4 + 1] = vb.y; tb[(rr0 + 32) * 65 + c4 + 2] = vb.z; tb[(rr0 + 32) * 65 + c4 + 3] = vb.w;
            __syncthreads();
            bf16_t* dcur = dstp;
            if (t + G < T_ALL) { N = decode(t + G, srcp, dstp, ldd); va = *reinterpret_cast<const float4*>(srcp); vb = *reinterpret_cast<const float4*>(srcp + (size_t)32 * N); }
            float v[8];
#pragma unroll
            for (int j = 0; j < 8; ++j) v[j] = tb[(kg * 8 + j) * 65 + nn];
            const u32x4_ wv = {cvtpk2(v[0], v[1]), cvtpk2(v[2], v[3]), cvtpk2(v[4], v[5]), cvtpk2(v[6], v[7])};
            *reinterpret_cast<u32x4_*>(dcur) = wv;
        }
        __syncthreads();
    }
    for (int i = wg * 512 + tid; i < SEQ * 64; i += G * 512) { const int pos = i >> 6, d = i & 63, fi = d & 31; const int base = d < 32 ? (pos >> 6) : (pos & 63);
        const float inv = powf(10000.f, -(float)fi / 32.f); const float ang = (float)base * inv; p.cos_t[i] = cosf(ang); p.sin_t[i] = sinf(ang); }
    for (int i = wg * 512 + tid; i < 2048; i += G * 512) { const float x0 = p.clb[i], x1 = p.clb[2048 + i], x2 = p.clb[4096 + i], x3 = p.clb[6144 + i];
        const float mx = fmaxf(fmaxf(x0, x1), fmaxf(x2, x3)); const float e0 = expf(x0 - mx), e1 = expf(x1 - mx), e2 = expf(x2 - mx), e3 = expf(x3 - mx); const float inv = 1.f / (e0 + e1 + e2 + e3);
        p.lbv[i] = 0.f; p.lbv[2048 + i] = e1 * inv; p.lbv[4096 + i] = (e1 + e2) * inv; p.lbv[6144 + i] = (e1 + e2 + e3) * inv; }
}

__device__ __forceinline__ void ph_norm(const Params& p, int l) {
    const int tid = tidx(), w = tid >> 6, lane = tid & 63;
    const float* g = p.norm_g + l * DM;
    const int nwv = gridDim.x * 8, per = (TT + nwv - 1) / nwv, gw = blockIdx.x * 8 + w;
    const int r0 = gw * per, r1 = (r0 + per < TT) ? r0 + per : TT;
    auto rowsrc = [&](int row) __attribute__((always_inline)) -> const float* { const int b = row / TPB, pp = row - b * TPB;
        return l == 0 ? (pp < CTXL ? p.ctx + ((size_t)b * CTXL + pp) * DM : p.x + ((size_t)b * SEQ + pp - CTXL) * DM) : p.resid + (size_t)row * DM; };
    float4 v[8], vn[8], gv[8], sh[8], sc[8];
#pragma unroll
    for (int i = 0; i < 8; ++i) gv[i] = *reinterpret_cast<const float4*>(g + i * 256 + lane * 4);
    int cur_mr = -1;
    if (r0 < r1) { const float* src = rowsrc(r0);
#pragma unroll
        for (int i = 0; i < 8; ++i) v[i] = *reinterpret_cast<const float4*>(src + i * 256 + lane * 4); }
    for (int row = r0; row < r1; ++row) {
        const int b = row / TPB, pp = row - b * TPB, mr = pp < CTXL ? 8 : b;
        if (row + 1 < r1) { const float* srcn = rowsrc(row + 1);
#pragma unroll
            for (int i = 0; i < 8; ++i) vn[i] = *reinterpret_cast<const float4*>(srcn + i * 256 + lane * 4); }
        if (mr != cur_mr) { cur_mr = mr; const float* md = p.mod + ((size_t)l * 9 + mr) * 6144;
#pragma unroll
            for (int i = 0; i < 8; ++i) { sh[i] = *reinterpret_cast<const float4*>(md + i * 256 + lane * 4); sc[i] = *reinterpret_cast<const float4*>(md + 2048 + i * 256 + lane * 4); } }
        float ss = 0.f;
#pragma unroll
        for (int i = 0; i < 8; ++i) ss += v[i].x * v[i].x + v[i].y * v[i].y + v[i].z * v[i].z + v[i].w * v[i].w;
        ss = wave_sum(ss);
        const float rstd = rsqrtf(ss * (1.f / DM) + 1e-6f);
#pragma unroll
        for (int i = 0; i < 8; ++i) { const int col = i * 256 + lane * 4;
            const float y0 = v[i].x * rstd * gv[i].x * (1.f + sc[i].x) + sh[i].x, y1 = v[i].y * rstd * gv[i].y * (1.f + sc[i].y) + sh[i].y;
            const float y2 = v[i].z * rstd * gv[i].z * (1.f + sc[i].z) + sh[i].z, y3 = v[i].w * rstd * gv[i].w * (1.f + sc[i].w) + sh[i].w;
            uint2 o; o.x = cvtpk2(y0, y1); o.y = cvtpk2(y2, y3);
            *reinterpret_cast<uint2*>(p.hbuf + (size_t)row * DM + col) = o; }
#pragma unroll
        for (int i = 0; i < 8; ++i) v[i] = vn[i];
    }
}

__device__ __forceinline__ void ph_kfix(const Params& p, int l) {
    const int tid = tidx(), w = tid >> 6, lane = tid & 63;
    const float g1 = p.b_kn[l * 128 + lane], g2 = p.b_kn[l * 128 + 64 + lane];
    const int stride = gridDim.x * 8;
    int row = blockIdx.x * 8 + w;
    bf16_t r1[4], r2[4], n1[4], n2[4]; float cs = 1.f, sn = 0.f, csn = 1.f, snn = 0.f;
#define KF_LOAD(ROW, A1, A2, CS, SN) do { const int b_ = (ROW) / TPB, pp_ = (ROW) - b_ * TPB; \
    _Pragma("unroll") for (int hh = 0; hh < 4; ++hh) { const bf16_t* kp_ = p.proj + pidx((ROW), hh < 2 ? COL_AK + hh * 128 : COL_BK + (hh - 2) * 128); A1[hh] = kp_[lane]; A2[hh] = kp_[64 + lane]; } \
    CS = 1.f; SN = 0.f; if (pp_ >= CTXL) { CS = p.cos_t[(pp_ - CTXL) * 64 + lane]; SN = p.sin_t[(pp_ - CTXL) * 64 + lane]; } } while (0)
    if (row < TT) KF_LOAD(row, r1, r2, cs, sn);
    for (; row < TT; row += stride) {
        const int b = row / TPB, pp = row - b * TPB; const bool lat = pp >= CTXL;
        if (row + stride < TT) KF_LOAD(row + stride, n1, n2, csn, snn);
        float x1[4], x2[4];
#pragma unroll
        for (int hh = 0; hh < 4; ++hh) { x1[hh] = bf2f(r1[hh]); x2[hh] = bf2f(r2[hh]); }
        float ssa = x1[2] * x1[2] + x2[2] * x2[2], ssb = x1[3] * x1[3] + x2[3] * x2[3];
#pragma unroll
        for (int o = 32; o >= 1; o >>= 1) { ssa += __shfl_xor(ssa, o); ssb += __shfl_xor(ssb, o); }
        const float ra = rsqrtf(ssa * (1.f / 128.f) + 1e-6f), rb = rsqrtf(ssb * (1.f / 128.f) + 1e-6f);
        x1[2] *= ra * g1; x2[2] *= ra * g2; x1[3] *= rb * g1; x2[3] *= rb * g2;
#pragma unroll
        for (int hh = 0; hh < 4; ++hh) {
            if (hh < 2 && !lat) continue;
            bf16_t* kp = p.proj + pidx(row, hh < 2 ? COL_AK + hh * 128 : COL_BK + (hh - 2) * 128);
            const float y1 = x1[hh] * cs - x2[hh] * sn, y2 = x2[hh] * cs + x1[hh] * sn;
            kp[lane] = f2bf(y1); kp[64 + lane] = f2bf(y2); }
#pragma unroll
        for (int hh = 0; hh < 4; ++hh) { r1[hh] = n1[hh]; r2[hh] = n2[hh]; }
        cs = csn; sn = snn;
    }
#undef KF_LOAD
}

__device__ __forceinline__ void ph_ccomb(const Params& p, int l) {
    const int tid = tidx(), w = tid >> 6, lane = tid & 63;
    const float2 gn = *reinterpret_cast<const float2*>(p.c_gn + l * 128 + lane * 2);
    const int stride = gridDim.x * 8;
    int row = blockIdx.x * 8 + w;
    float2 fa[8], fb[8], na[8], nb[8]; unsigned zz[8], nz[8];
#define CC_LOAD(ROW, A, B, Z) do { _Pragma("unroll") for (int h = 0; h < 8; ++h) { const size_t off_ = (size_t)(ROW) * 1024 + h * 128 + lane * 2; \
    A[h] = *reinterpret_cast<const float2*>(p.pbuf + off_); B[h] = *reinterpret_cast<const float2*>(p.pbuf + (size_t)TT * 1024 + off_); \
    Z[h] = *reinterpret_cast<const unsigned*>(p.proj + pidx((ROW), COL_CZ + h * 128) + lane * 2); } } while (0)
    if (row < TT) CC_LOAD(row, fa, fb, zz);
    for (; row < TT; row += stride) {
        if (row + stride < TT) CC_LOAD(row + stride, na, nb, nz);
        float s0[8], s1[8], ss[8];
#pragma unroll
        for (int h = 0; h < 8; ++h) { s0[h] = fa[h].x + fb[h].x; s1[h] = fa[h].y + fb[h].y; ss[h] = s0[h] * s0[h] + s1[h] * s1[h]; }
#pragma unroll
        for (int o = 32; o >= 1; o >>= 1) {
#pragma unroll
            for (int h = 0; h < 8; ++h) ss[h] += __shfl_xor(ss[h], o); }
#pragma unroll
        for (int h = 0; h < 8; ++h) { const float rstd = rsqrtf(ss[h] * (1.f / 128.f) + 1e-6f);
            const float z0 = __uint_as_float(zz[h] << 16), z1 = __uint_as_float(zz[h] & 0xffff0000u);
            *reinterpret_cast<unsigned*>(p.gin + (size_t)row * 3072 + 2048 + h * 128 + lane * 2) = cvtpk2(s0[h] * rstd * gn.x * silu_fast(z0), s1[h] * rstd * gn.y * silu_fast(z1)); }
#pragma unroll
        for (int h = 0; h < 8; ++h) { fa[h] = na[h]; fb[h] = nb[h]; zz[h] = nz[h]; }
    }
#undef CC_LOAD
}

__device__ __forceinline__ void ph_final(const Params& p) {
    const int tid = tidx(), w = tid >> 6, lane = tid & 63;
    for (int r = blockIdx.x * 8 + w; r < NB * SEQ; r += gridDim.x * 8) {
        const int b = r / SEQ, t = r - b * SEQ;
        const float* src = p.resid + ((size_t)b * TPB + CTXL + t) * DM;
        float4 v[8]; float ss = 0.f;
#pragma unroll
        for (int i = 0; i < 8; ++i) { v[i] = *reinterpret_cast<const float4*>(src + i * 256 + lane * 4); ss += v[i].x * v[i].x + v[i].y * v[i].y + v[i].z * v[i].z + v[i].w * v[i].w; }
        ss = wave_sum(ss);
        const float rstd = rsqrtf(ss * (1.f / DM) + 1e-6f);
#pragma unroll
        for (int i = 0; i < 8; ++i) { const int col = i * 256 + lane * 4; const float4 gv = *reinterpret_cast<const float4*>(p.final_g + col);
            float4 o; o.x = v[i].x * rstd * gv.x; o.y = v[i].y * rstd * gv.y; o.z = v[i].z * rstd * gv.z; o.w = v[i].w * rstd * gv.w;
            *reinterpret_cast<float4*>(p.out + (size_t)r * DM + col) = o; }
    }
}

__device__ __forceinline__ void ph_attn(const Params& p, int l, unsigned char* lds) {
    const int G = gridDim.x; const bool with_ctx = l < DEPTH - 1;
    for (int pass = 0; pass < 2; ++pass)
        for (int i = blockIdx.x; i < 512; i += G) {
            const int c = i & 255, rnd = i >> 8, xcd = c & 7, j = c >> 3, gi = xcd + 8 * rnd, b = gi >> 1, kvh = gi & 1, h = kvh * 4 + (j >> 3), qt = j & 7;
            if (pass == 0) att::attn_item<1>(p, l, b, h, qt, (char*)lds); else att::attn_item<0>(p, l, b, h, qt, (char*)lds);
        }
    if (with_ctx)
        for (int i = blockIdx.x; i < 128; i += G) { const int md = i & 1, bh = i >> 1, b = bh >> 3, h = bh & 7;
            if (md) att::attn_item<1>(p, l, b, h, 8, (char*)lds); else att::attn_item<0>(p, l, b, h, 8, (char*)lds); }
}

namespace xb {
#define XB_TMO      128
#define XB_XCNT(j)  (256  + 64 * (j))
#define XB_XSUB(j)  (1280 + 64 * (j))
#define XB_XGEN(j)  (2304 + 64 * (j))
#define XB_TOP      3328
#define XB_TOPGEN   3392
#define XCD_BAR_WORDS 3456
#define XB_SPIN_CAP (1u << 18)
#define LAS __attribute__((address_space(3)))

__device__ __forceinline__ unsigned xb_ld(unsigned* p)              { return __hip_atomic_load(p, __ATOMIC_RELAXED, __HIP_MEMORY_SCOPE_AGENT); }
__device__ __forceinline__ unsigned xb_add(unsigned* p, unsigned v) { return __hip_atomic_fetch_add(p, v, __ATOMIC_RELAXED, __HIP_MEMORY_SCOPE_AGENT); }
__device__ __forceinline__ unsigned xb_xcc_id() { return (unsigned)__builtin_amdgcn_s_getreg((3 << 11) | 20) & 0xFu; }
#define XB_SPIN(cond, bar) do { unsigned _sp = 0; while (cond) { __builtin_amdgcn_s_sleep(1); \
    if ((++_sp & 255u) == 0u) { if (xb_ld(&(bar)[XB_TMO])) break; if (_sp > XB_SPIN_CAP) { atomicAdd(&(bar)[XB_TMO], 1u); break; } } } } while (0)

struct XcdBarrier {
    unsigned* bar; unsigned x;
    volatile LAS unsigned* st;
};

__device__ __forceinline__ XcdBarrier xcd_barrier_post(unsigned* bar, volatile LAS unsigned* st) {
    XcdBarrier b; b.bar = bar; b.x = xb_xcc_id(); b.st = st;
    if (threadIdx.x == 0) (void)xb_add(&bar[XB_XCNT(b.x)], 1u);
    return b;
}
__device__ __forceinline__ void xcd_barrier_complete(unsigned* bar, unsigned x, unsigned& nloc, unsigned& nx) {
    const unsigned G = gridDim.x * gridDim.y * gridDim.z;
    unsigned sum, cnt, mine, sp = 0u;
    for (;;) {
        sum = 0u; cnt = 0u; mine = 0u;
#pragma unroll
        for (unsigned j = 0; j < 16; ++j) { const unsigned c = xb_ld(&bar[XB_XCNT(j)]); sum += c; cnt += (c > 0u) ? 1u : 0u; mine = (j == x) ? c : mine; }
        if (sum == G) break;
        __builtin_amdgcn_s_sleep(1);
        if ((++sp & 255u) == 0u) { if (xb_ld(&bar[XB_TMO])) break; if (sp > XB_SPIN_CAP) { atomicAdd(&bar[XB_TMO], 1u); break; } }
    }
    nloc = mine > 0u ? mine : 1u; nx = cnt > 0u ? cnt : 1u;
}

__device__ __forceinline__ void xcd_barrier(const XcdBarrier& b) {
    asm volatile("s_waitcnt vmcnt(0)" ::: "memory");
    __syncthreads();
    if (threadIdx.x == 0) {
        unsigned* bar = b.bar;
        __builtin_amdgcn_s_waitcnt(0);
        unsigned nloc = b.st[0], nx = b.st[1];
        if (nloc == 0u) { xcd_barrier_complete(bar, b.x, nloc, nx); b.st[0] = nloc; b.st[1] = nx; }
        const unsigned old = xb_add(&bar[XB_XSUB(b.x)], 1u);
        const unsigned gen = old / nloc;
        if (old + 1u == (gen + 1u) * nloc) {
            __builtin_amdgcn_fence(__ATOMIC_RELEASE, "agent");
            asm volatile("s_waitcnt vmcnt(0)" ::: "memory");
            const unsigned og = xb_add(&bar[XB_TOP], 1u);
            const unsigned tg = og / nx;
            if (og + 1u == (tg + 1u) * nx) xb_add(&bar[XB_TOPGEN], 1u);
            else XB_SPIN(xb_ld(&bar[XB_TOPGEN]) == tg, bar);
            __builtin_amdgcn_fence(__ATOMIC_ACQUIRE, "agent");
            xb_add(&bar[XB_XGEN(b.x)], 1u);
            asm volatile("s_waitcnt vmcnt(0)" ::: "memory");
        } else {
            XB_SPIN(xb_ld(&bar[XB_XGEN(b.x)]) == gen, bar);
            __builtin_amdgcn_fence(__ATOMIC_ACQUIRE, "agent");
            asm volatile("s_waitcnt vmcnt(0)" ::: "memory");
        }
    }
    __syncthreads();
}

}
__global__ void __launch_bounds__(512, 2) mega_fwd(Params p) {
    extern __shared__ __attribute__((aligned(16))) unsigned char lds[];
    cg::grid_group grid_ = cg::this_grid();
#define GSYNC_CG() do { __builtin_amdgcn_fence(__ATOMIC_RELEASE, "agent"); asm volatile("s_waitcnt vmcnt(0)" ::: "memory"); grid_.sync(); \
        __builtin_amdgcn_fence(__ATOMIC_ACQUIRE, "agent"); asm volatile("s_waitcnt vmcnt(0)" ::: "memory"); } while (0)
    volatile LAS unsigned* xst_ = (volatile LAS unsigned*)(lds + 131072);
    if (threadIdx.x == 0) { xst_[0] = 0u; xst_[1] = 0u; }
    __syncthreads();
    const xb::XcdBarrier xbar_ = xb::xcd_barrier_post(p.bar, xst_);
#define GSYNC() xb::xcd_barrier(xbar_)
    const int G = gridDim.x, c = blockIdx.x;
    grid_.sync();
    ph_prologue(p, lds);
    GSYNC();
    for (int l = 0; l < DEPTH; ++l) {
        const bool last = l == DEPTH - 1;
        ph_norm(p, l);
        GSYNC();
        { pg8::Gemm g; g.A = p.hbuf; g.Bt = p.WinT + (size_t)l * NP * DM; g.M = TT; g.N = NP; g.K = DM;
          Order S; if (last) { S.init(64, 64, 1, 1, G, c); S.tail = 128; } else S.init(72, 64, 1, 0, G, c);
          EpiProj E; E.O = p.proj;
          pg8::gemm_phase<EpiProj, Order, false>((PG8_LAS unsigned char*)lds, g, S, E, nullptr); }
        GSYNC();
        ph_kfix(p, l);
        for (int i = c; i < 256; i += G) {
            const int x = i & 7, k = i >> 3;
            hg::hgrn_item(p, l, ((x + 8 * (k >> 1)) << 1) | (k & 1), lds); }
        GSYNC();
        ph_attn(p, l, lds);
        ph_ccomb(p, l);
        GSYNC();
        { pg8::Gemm g; g.A = p.gin; g.Bt = p.WbT + (size_t)l * 3 * DM * 1024; g.M = TT; g.N = DM; g.K = 3072;
          Order S; S.init(last ? 64 : 72, 8, 1, last ? 1 : 0, G, c); EpiBranch E; E.proj = p.proj; E.merged = p.hbuf;
          pg8::gemm_phase<EpiBranch, Order, false>((PG8_LAS unsigned char*)lds, g, S, E, nullptr); }
        GSYNC();
        { pg8::Gemm g; g.A = p.hbuf; g.Bt = p.WoT + (size_t)l * DM * DM; g.M = TT; g.N = DM; g.K = DM;
          Order S; S.init(last ? 64 : 72, 8, 1, last ? 1 : 0, G, c); EpiOut E; E.x = p.x; E.ctx = p.ctx; E.resid = p.resid; E.modl = p.mod + (size_t)l * 9 * 6144; E.layer0 = l == 0;
          pg8::gemm_phase<EpiOut, Order, false>((PG8_LAS unsigned char*)lds, g, S, E, nullptr); }
        GSYNC();
    }
    ph_final(p);
}

extern "C" void kernel_launch(void* const* d_in, const int* in_sizes, int n_in, void* d_out, int out_size, void* d_ws, size_t ws_size, hipStream_t stream) {
    constexpr size_t SZ_WIN = (size_t)DEPTH * NP * DM * 2, SZ_WB = (size_t)DEPTH * 3 * DM * 1024 * 2, SZ_WO = (size_t)DEPTH * DM * DM * 2, SZ_RES = (size_t)TT * DM * 4, SZ_H = (size_t)TT * DM * 2,
                     SZ_PROJ = (size_t)TT * NP * 2, SZ_GIN = (size_t)3 * TT * 1024 * 2, SZ_PB = (size_t)TT * DM * 4, SZ_MOD = (size_t)DEPTH * 9 * 6144 * 4, SZ_LB = 8192 * 4, SZ_ROPE = (size_t)SEQ * 64 * 4;
    constexpr size_t O_WIN = 0, O_WB = O_WIN + SZ_WIN, O_WO = O_WB + SZ_WB, O_RES = O_WO + SZ_WO, O_H = O_RES + SZ_RES, O_PROJ = O_H + SZ_H, O_GIN = O_PROJ + SZ_PROJ, O_PB = O_GIN + SZ_GIN,
                     O_MOD = O_PB + SZ_PB, O_LB = O_MOD + ((SZ_MOD + 255) / 256) * 256, O_COS = O_LB + SZ_LB, O_SIN = O_COS + SZ_ROPE, O_BAR = O_SIN + SZ_ROPE, O_END = O_BAR + 16384;
    static int grid_blocks = 0;
    if (grid_blocks == 0) {
        if (n_in != 18 || out_size != NB * SEQ * DM || ws_size < O_END) { fprintf(stderr, "kernel_launch: unexpected shapes (n_in %d out %d ws %zu need %zu)\n", n_in, out_size, ws_size, (size_t)O_END); grid_blocks = -1; return; }
        int dev = 0, cus = 0, per_cu = 0;
        hipGetDevice(&dev);
        hipDeviceGetAttribute(&cus, hipDeviceAttributeMultiprocessorCount, dev);
        if (hipFuncSetAttribute((const void*)mega_fwd, hipFuncAttributeMaxDynamicSharedMemorySize, LDS_BYTES) != hipSuccess) { fprintf(stderr, "kernel_launch: hipFuncSetAttribute failed\n"); grid_blocks = -1; return; }
        if (hipOccupancyMaxActiveBlocksPerMultiprocessor(&per_cu, (const void*)mega_fwd, 512, LDS_BYTES) != hipSuccess || per_cu < 1) { fprintf(stderr, "kernel_launch: occupancy query failed (%d)\n", per_cu); (void)hipGetLastError(); per_cu = 1; }
        grid_blocks = cus * per_cu;
    }
    if (grid_blocks < 0) return;
    Params p{};
    p.x = (const float*)d_in[0]; p.c = (const float*)d_in[1]; p.ctx = (const float*)d_in[2]; p.c_ctx = (const float*)d_in[3]; p.ada_w = (const float*)d_in[4]; p.ada_b = (const float*)d_in[5];
    p.norm_g = (const float*)d_in[6]; p.w_in = (const float*)d_in[7]; p.a_sink = (const float*)d_in[8]; p.b_qn = (const float*)d_in[9]; p.b_kn = (const float*)d_in[10]; p.clb = (const float*)d_in[11];
    p.c_gn = (const float*)d_in[12]; p.w_ba = (const float*)d_in[13]; p.w_bb = (const float*)d_in[14]; p.w_bc = (const float*)d_in[15]; p.w_out = (const float*)d_in[16]; p.final_g = (const float*)d_in[17];
    p.out = (float*)d_out;
    char* ws = (char*)d_ws;
    p.WinT = (bf16_t*)(ws + O_WIN); p.WbT = (bf16_t*)(ws + O_WB); p.WoT = (bf16_t*)(ws + O_WO); p.resid = (float*)(ws + O_RES); p.hbuf = (bf16_t*)(ws + O_H); p.proj = (bf16_t*)(ws + O_PROJ);
    p.gin = (bf16_t*)(ws + O_GIN); p.pbuf = (float*)(ws + O_PB); p.mod = (float*)(ws + O_MOD); p.lbv = (float*)(ws + O_LB); p.cos_t = (float*)(ws + O_COS); p.sin_t = (float*)(ws + O_SIN); p.bar = (unsigned*)(ws + O_BAR);
    if (hipMemsetAsync(ws + O_BAR, 0, 16384, stream) != hipSuccess) { fprintf(stderr, "kernel_launch: memset of the barrier word failed\n"); return; }
    void* args[] = {&p};
    const hipError_t e = hipLaunchCooperativeKernel((const void*)mega_fwd, dim3(grid_blocks), dim3(512), args, LDS_BYTES, stream);
    if (e != hipSuccess) fprintf(stderr, "kernel_launch: cooperative launch failed: %s (grid %d)\n", hipGetErrorString(e), grid_blocks);
}
```
